# Optimizing an MI355X kernel written in HIP

```python
import jax, jax.numpy as jnp
from jax import lax
import numpy as np

D_MODEL = 1024
BATCH = 2
SEQ = 8192
DEPTH = 1

GLA_HEADS = 4
GLA_DK = 128
GLA_DV = 256
GLA_KW = GLA_HEADS * GLA_DK
GLA_VW = GLA_HEADS * GLA_DV
GATE_RANK = 16
GATE_NORMALIZER = 16.0
GLA_CHUNK = 64
CONV_WIDTH = 1024
CONV_GROUPS = 8
CONV_K = 3
PLE_DIM = 256
EPS = 1e-6

SPLITS = [GLA_KW, GLA_KW, GLA_VW, GLA_VW, GATE_RANK,
          CONV_WIDTH, CONV_WIDTH, CONV_WIDTH, CONV_WIDTH,
          D_MODEL, D_MODEL]
IN_COLS = sum(SPLITS)

kernel_name = "hybrid_gla_shortconv_gated_merge"


def rms_norm(x, g):
    xf = x.astype(jnp.float32)
    y = xf * lax.rsqrt(jnp.mean(xf * xf, axis=-1, keepdims=True) + EPS)
    return (y * g.astype(jnp.float32)).astype(x.dtype)


def gla_chunked(q, k, v, gk):
    bsz, s, h, dk = q.shape
    dv = v.shape[-1]
    n = s // GLA_CHUNK

    def to_chunks(t):
        return t.astype(jnp.float32).reshape(bsz, n, GLA_CHUNK, h, t.shape[-1]).transpose(1, 0, 3, 2, 4)

    q, k, v, gk = to_chunks(q) * (dk ** -0.5), to_chunks(k), to_chunks(v), to_chunks(gk)
    b = jnp.cumsum(gk, axis=3)
    b_last = b[:, :, :, -1:, :]
    q_in = q * jnp.exp(b)
    k_in = k * jnp.exp(-b)
    k_dec = k * jnp.exp(b_last - b)
    causal = jnp.tril(jnp.ones((GLA_CHUNK, GLA_CHUNK), dtype=bool))
    a = jnp.where(causal, jnp.einsum('nbhid,nbhjd->nbhij', q_in, k_in), 0.0)
    o_intra = jnp.einsum('nbhij,nbhjv->nbhiv', a, v)
    decay = jnp.exp(b_last[:, :, :, 0, :])

    def step(state, xs):
        q_n, k_n, v_n, d_n = xs
        o_n = jnp.einsum('bhcd,bhdv->bhcv', q_n, state)
        state = d_n[..., None] * state + jnp.einsum('bhcd,bhcv->bhdv', k_n, v_n)
        return state, o_n

    state0 = jnp.zeros((bsz, h, dk, dv), jnp.float32)
    _, o_inter = lax.scan(step, state0, (q_in, k_dec, v, decay))
    o = o_intra + o_inter
    return o.transpose(1, 0, 3, 2, 4).reshape(bsz, s, h, dv)


def causal_dwconv(u, w):
    s = u.shape[1]
    u_pad = jnp.pad(u, ((0, 0), (CONV_K - 1, 0), (0, 0)))
    y = w[0] * u_pad[:, 0:s, :]
    for j in range(1, CONV_K):
        y = y + w[j] * u_pad[:, j:j + s, :]
    return y


def setup_inputs(seed: int = 0) -> dict:
    key = jax.random.key(seed)
    ks = jax.random.split(key, 20)
    nrm = lambda k, shape, scale: jax.random.normal(k, shape, jnp.float32) * scale
    gain = lambda k, shape: 1.0 + 0.05 * jax.random.normal(k, shape, jnp.float32)
    return {
        "x": nrm(ks[0], (BATCH, SEQ, D_MODEL), 1.0),
        "p": nrm(ks[1], (DEPTH, BATCH, SEQ, PLE_DIM), 1.0),
        "norm_mix_g": gain(ks[2], (DEPTH, D_MODEL)),
        "w_in": nrm(ks[3], (DEPTH, D_MODEL, IN_COLS), D_MODEL ** -0.5),
        "b_merge": nrm(ks[4], (DEPTH, 2 * D_MODEL), 0.02),
        "w_gk2": nrm(ks[5], (DEPTH, GATE_RANK, GLA_KW), GATE_RANK ** -0.5),
        "b_gk": nrm(ks[6], (DEPTH, GLA_KW), 0.02),
        "gla_norm_g": gain(ks[7], (DEPTH, GLA_DV)),
        "conv_w": nrm(ks[8], (DEPTH, CONV_K, CONV_WIDTH), CONV_K ** -0.5),
        "w_branch_a": nrm(ks[9], (DEPTH, GLA_VW, D_MODEL), GLA_VW ** -0.5),
        "w_branch_c": nrm(ks[10], (DEPTH, CONV_WIDTH, D_MODEL), CONV_WIDTH ** -0.5),
        "w_out": nrm(ks[11], (DEPTH, D_MODEL, D_MODEL), D_MODEL ** -0.5),
        "norm_ple_g": gain(ks[12], (DEPTH, D_MODEL)),
        "w_ple_gate": nrm(ks[13], (DEPTH, D_MODEL, D_MODEL), D_MODEL ** -0.5),
        "w_ple_proj": nrm(ks[14], (DEPTH, PLE_DIM, D_MODEL), PLE_DIM ** -0.5),
        "norm_final_g": gain(ks[15], (D_MODEL,)),
    }


def reference(x, p, norm_mix_g, w_in, b_merge, w_gk2, b_gk, gla_norm_g, conv_w,
              w_branch_a, w_branch_c, w_out, norm_ple_g, w_ple_gate, w_ple_proj,
              norm_final_g):
    bsz, s, _ = x.shape
    idx = np.cumsum(SPLITS)[:-1].tolist()
    for i in range(DEPTH):
        h = rms_norm(x, norm_mix_g[i])
        proj = jnp.einsum('bsd,dc->bsc', h, w_in[i])
        (q, k, v, z_a, gk_low, cb, cc, xc, z_c, g_a, g_c) = jnp.split(proj, idx, axis=-1)

        gk = jax.nn.log_sigmoid((jnp.einsum('bsr,rk->bsk', gk_low, w_gk2[i]) + b_gk[i]).astype(jnp.float32)) / GATE_NORMALIZER
        o = gla_chunked(q.reshape(bsz, s, GLA_HEADS, GLA_DK),
                        k.reshape(bsz, s, GLA_HEADS, GLA_DK),
                        v.reshape(bsz, s, GLA_HEADS, GLA_DV),
                        gk.reshape(bsz, s, GLA_HEADS, GLA_DK))
        o = rms_norm(o, gla_norm_g[i]).reshape(bsz, s, GLA_VW).astype(x.dtype)
        y_a = jnp.einsum('bsv,vd->bsd', o * jax.nn.silu(z_a), w_branch_a[i])

        u = causal_dwconv(cc * xc, conv_w[i])
        y_c = jnp.einsum('bsc,cd->bsd', (cb * u) * jax.nn.silu(z_c), w_branch_c[i])

        b_ga, b_gc = b_merge[i][:D_MODEL], b_merge[i][D_MODEL:]
        merged = jax.nn.sigmoid(g_a + b_ga) * y_a + jax.nn.sigmoid(g_c + b_gc) * y_c
        x = x + jnp.einsum('bsd,de->bse', merged, w_out[i])

        ple_gate = jax.nn.sigmoid(jnp.einsum('bsd,de->bse', rms_norm(x, norm_ple_g[i]), w_ple_gate[i]))
        x = x + ple_gate * jnp.einsum('bsq,qd->bsd', p[i], w_ple_proj[i])
    return rms_norm(x, norm_final_g)
```

```cpp
#include <hip/hip_runtime.h>
#include <cstdio>
#include <cstdint>
namespace pg8 {
#define PG8_LAS __attribute__((address_space(3)))
typedef unsigned short bf16_t;
typedef short bf16x8 __attribute__((ext_vector_type(8)));
typedef float f32x4 __attribute__((ext_vector_type(4)));
typedef unsigned u32x4 __attribute__((ext_vector_type(4)));
constexpr int BM = 256, BK = 64, HALF = 128, HTB = HALF * BK * 2  , STAGE_BYTES = 8 * HTB, NXCD = 8, WGM = 8;

__host__ __device__ __forceinline__ int lds_byte(int r, int c) { const int st = (r >> 4) * 2 + (c >> 5), rr = r & 15, cc = c & 31, ob = rr * 64 + cc * 2; return st * 1024 + (ob ^ (((ob >> 9) & 1) << 5)); }
__host__ __device__ __forceinline__ void stage_rc(int b, int& R, int& C) { const int st = b / 1024, sb = b % 1024, swz = sb ^ (((sb >> 9) & 1) << 5); R = (st >> 1) * 16 + swz / 64; C = (st & 1) * 32 + (swz % 64) / 2; }
__host__ __device__ __forceinline__ int perm32(int rho) { const int n = rho >> 4, i = rho & 15; return 8 * (i >> 2) + 4 * n + (i & 3); }

struct Unit { int pm, pn; };
struct Gemm { const bf16_t* A; const bf16_t* Bt; int M, N, K; };

struct StaticOrder {
    int nM, nN, nwg, G, c;
    __host__ __device__ void init(int M, int N, int G_, int c_) { nM = M / BM; nN = N / BM; nwg = nM * nN; G = G_; c = c_; }
    __host__ __device__ bool next(int i, Unit& u) const {
        const long L = (long)i * G + c; if (L >= nwg) return false;
        int wgid = (int)L; { const int q = nwg / NXCD, r = nwg % NXCD, xcd = wgid % NXCD, off = wgid / NXCD; wgid = (xcd < r ? xcd * (q + 1) : r * (q + 1) + (xcd - r) * q) + off; }
        const int nig = WGM * nN, gid = wgid / nig, fm = gid * WGM, gsz = (nM - fm) < WGM ? (nM - fm) : WGM;
        u.pm = fm + ((wgid % nig) % gsz); u.pn = (wgid % nig) / gsz; return true;
    }
    __device__ __forceinline__ void a_ready(const Unit&) const {}
    __device__ __forceinline__ void done(const Unit&) const {}
};

__device__ __forceinline__ unsigned cvt_pk_bf16(float lo, float hi) { unsigned r; asm volatile("v_cvt_pk_bf16_f32 %0, %1, %2" : "=v"(r) : "v"(lo), "v"(hi)); return r; }
typedef float f32x2 __attribute__((ext_vector_type(2)));
typedef unsigned u32x2 __attribute__((ext_vector_type(2)));
__device__ __forceinline__ float bf_lo(unsigned w) { return __uint_as_float(w << 16); }
__device__ __forceinline__ float bf_hi(unsigned w) { return __uint_as_float(w & 0xffff0000u); }
__device__ __forceinline__ float fsigmoid(float v) { return __builtin_amdgcn_rcpf(1.f + __expf(-v)); }
__device__ __forceinline__ float fsilu(float v) { return v * __builtin_amdgcn_rcpf(1.f + __expf(-v)); }
__device__ __forceinline__ u32x4 pack8(const f32x4 a, const f32x4 b) { u32x4 w; w.x = cvt_pk_bf16(a[0], a[1]); w.y = cvt_pk_bf16(a[2], a[3]); w.z = cvt_pk_bf16(b[0], b[1]); w.w = cvt_pk_bf16(b[2], b[3]); return w; }
__device__ __forceinline__ void unpack8(const u32x4 w, f32x4& a, f32x4& b) { a = (f32x4){bf_lo(w.x), bf_hi(w.x), bf_lo(w.y), bf_hi(w.y)}; b = (f32x4){bf_lo(w.z), bf_hi(w.z), bf_lo(w.w), bf_hi(w.w)}; }
__device__ __forceinline__ f32x4 silu4(f32x4 v) { return (f32x4){fsilu(v[0]), fsilu(v[1]), fsilu(v[2]), fsilu(v[3])}; }
__device__ __forceinline__ f32x4 sigm4(f32x4 v) { return (f32x4){fsigmoid(v[0]), fsigmoid(v[1]), fsigmoid(v[2]), fsigmoid(v[3])}; }

struct EpiIn {
    static constexpr bool PERM = true, AFTER_DRAIN = false, MIDK = false;
    bf16_t *QK, *ACAT, *SZA, *WCX, *R, *SGC; const float* b_merge; int mid_t;
    __device__ __forceinline__ void mid(f32x4 (&)[2][2][4][2], const Unit&, int, int, int, int) const {}
    __device__ __forceinline__ void operator()(const f32x4 (&acc)[2][2][4][2], const Unit& u, int wr, int wc, int fr, int fq) const {
        const int pn = u.pn, row0 = u.pm * BM + wr * 64 + fr, c8 = wc * 32 + 8 * fq;
        __builtin_amdgcn_sched_barrier(0); asm volatile("s_nop 15\n\ts_nop 15\n\ts_nop 15\n\ts_nop 15" ::: "memory"); __builtin_amdgcn_sched_barrier(0);
        if (pn < 12) {
            bf16_t* base; int ldc, colt; const bool act = pn >= 8;
            if (pn < 4) { base = QK; ldc = 1024; colt = pn * 256; } else if (pn < 8) { base = ACAT; ldc = 2048; colt = (pn - 4) * 256; } else { base = SZA; ldc = 1024; colt = (pn - 8) * 256; }
#pragma unroll
            for (int ai = 0; ai < 2; ++ai)
#pragma unroll
                for (int m = 0; m < 4; ++m) { bf16_t* rowp = base + (size_t)(row0 + ai * HALF + m * 16) * ldc + colt + c8;
#pragma unroll
                    for (int bj = 0; bj < 2; ++bj) { f32x4 v0 = acc[ai][bj][m][0], v1 = acc[ai][bj][m][1]; if (act) { v0 = silu4(v0); v1 = silu4(v1); }
                        *(u32x4*)(rowp + bj * HALF) = pack8(v0, v1); } }
        } else if (pn < 28) {
            const bool isw = pn < 20; const int j = isw ? pn - 12 : pn - 20; bf16_t* base = isw ? WCX : ACAT + 1024; const int ldc = isw ? 1024 : 2048;
#pragma unroll
            for (int ai = 0; ai < 2; ++ai)
#pragma unroll
                for (int m = 0; m < 4; ++m) { bf16_t* rowp = base + (size_t)(row0 + ai * HALF + m * 16) * ldc + j * HALF + c8;
                    f32x4 b0 = acc[ai][1][m][0], b1 = acc[ai][1][m][1]; if (!isw) { b0 = silu4(b0); b1 = silu4(b1); }
                    *(u32x4*)rowp = pack8(acc[ai][0][m][0] * b0, acc[ai][0][m][1] * b1); }
        } else {
            const int j = pn - 28, ch = j * HALF + c8;
            const f32x4 ba0 = *(const f32x4*)(b_merge + ch), ba1 = *(const f32x4*)(b_merge + ch + 4), bc0 = *(const f32x4*)(b_merge + 1024 + ch), bc1 = *(const f32x4*)(b_merge + 1024 + ch + 4);
#pragma unroll
            for (int ai = 0; ai < 2; ++ai)
#pragma unroll
                for (int m = 0; m < 4; ++m) { const size_t off = (size_t)(row0 + ai * HALF + m * 16) * 1024 + ch;
                    const f32x4 sa0 = sigm4(acc[ai][0][m][0] + ba0), sa1 = sigm4(acc[ai][0][m][1] + ba1), sc0 = sigm4(acc[ai][1][m][0] + bc0), sc1 = sigm4(acc[ai][1][m][1] + bc1);
                    f32x4 r0, r1;
#pragma unroll
                    for (int e = 0; e < 4; ++e) { r0[e] = sa0[e] * __builtin_amdgcn_rcpf(sc0[e]); r1[e] = sa1[e] * __builtin_amdgcn_rcpf(sc1[e]); }
                    *(u32x4*)(R + off) = pack8(r0, r1); *(u32x4*)(SGC + off) = pack8(sc0, sc1); }
        }
    }
};
struct EpiPlain {
    static constexpr bool PERM = true, AFTER_DRAIN = false, MIDK = false;
    bf16_t* O; int ldc; int mid_t;
    __device__ __forceinline__ void mid(f32x4 (&)[2][2][4][2], const Unit&, int, int, int, int) const {}
    __device__ __forceinline__ void operator()(const f32x4 (&acc)[2][2][4][2], const Unit& u, int wr, int wc, int fr, int fq) const {
        const int row0 = u.pm * BM + wr * 64 + fr, col0 = u.pn * BM + wc * 32 + 8 * fq;
        __builtin_amdgcn_sched_barrier(0); asm volatile("s_nop 15\n\ts_nop 15\n\ts_nop 15\n\ts_nop 15" ::: "memory"); __builtin_amdgcn_sched_barrier(0);
#pragma unroll
        for (int ai = 0; ai < 2; ++ai)
#pragma unroll
            for (int m = 0; m < 4; ++m) { bf16_t* rowp = O + (size_t)(row0 + ai * HALF + m * 16) * ldc + col0;
#pragma unroll
                for (int bj = 0; bj < 2; ++bj) *(u32x4*)(rowp + bj * HALF) = pack8(acc[ai][bj][m][0], acc[ai][bj][m][1]); }
    }
};
struct EpiMerge {
    static constexpr bool PERM = true, AFTER_DRAIN = false, MIDK = true;
    const bf16_t *R, *SGC; bf16_t* O; int mid_t;
    __device__ __forceinline__ void mid(f32x4 (&acc)[2][2][4][2], const Unit& u, int wr, int wc, int fr, int fq) const {
        int row0 = u.pm * BM + wr * 64 + fr, col0 = u.pn * BM + wc * 32 + 8 * fq; asm volatile("" : "+v"(row0), "+v"(col0));
#pragma unroll
        for (int ai = 0; ai < 2; ++ai)
#pragma unroll
            for (int m = 0; m < 4; ++m) { const bf16_t* rowp = R + (size_t)(row0 + ai * HALF + m * 16) * 1024 + col0;
#pragma unroll
                for (int bj = 0; bj < 2; ++bj) { f32x4 r0, r1; unpack8(*(const u32x4*)(rowp + bj * HALF), r0, r1); acc[ai][bj][m][0] *= r0; acc[ai][bj][m][1] *= r1; }
                if (m & 1) asm volatile("" ::: "memory"); }
    }
    __device__ __forceinline__ void operator()(const f32x4 (&acc)[2][2][4][2], const Unit& u, int wr, int wc, int fr, int fq) const {
        const int row0 = u.pm * BM + wr * 64 + fr, col0 = u.pn * BM + wc * 32 + 8 * fq;
#pragma unroll
        for (int ai = 0; ai < 2; ++ai)
#pragma unroll
            for (int m = 0; m < 4; ++m) { const size_t off = (size_t)(row0 + ai * HALF + m * 16) * 1024 + col0;
#pragma unroll
                for (int bj = 0; bj < 2; ++bj) { f32x4 s0, s1; unpack8(*(const u32x4*)(SGC + off + bj * HALF), s0, s1);
                    *(u32x4*)(O + off + bj * HALF) = pack8(acc[ai][bj][m][0] * s0, acc[ai][bj][m][1] * s1); }
                if (m & 1) asm volatile("" ::: "memory"); }
    }
};
struct EpiOut {
    static constexpr bool PERM = false, AFTER_DRAIN = false, MIDK = false;
    const float* x; float* x2; bf16_t* x2b; float* rowss; int mid_t;
    __device__ __forceinline__ void mid(f32x4 (&)[2][2][4][2], const Unit&, int, int, int, int) const {}
    __device__ __forceinline__ void operator()(const f32x4 (&acc)[2][2][4][2], const Unit& u, int wr, int wc, int fr, int fq) const {
        const int col0 = u.pn * BM + wc * 32 + 4 * fq;
#pragma unroll
        for (int ai = 0; ai < 2; ++ai)
#pragma unroll
            for (int m = 0; m < 4; ++m) { const int row = u.pm * BM + ai * HALF + wr * 64 + m * 16 + fr; const size_t off = (size_t)row * 1024 + col0; float s = 0.f;
#pragma unroll
                for (int bj = 0; bj < 2; ++bj)
#pragma unroll
                    for (int n = 0; n < 2; ++n) { const size_t c = off + bj * HALF + n * 16; const f32x4 o = *(const f32x4*)(x + c) + acc[ai][bj][m][n];
                        *(f32x4*)(x2 + c) = o; u32x2 w; w.x = cvt_pk_bf16(o[0], o[1]); w.y = cvt_pk_bf16(o[2], o[3]); *(u32x2*)(x2b + c) = w;
                        s += (o[0] * o[0] + o[1] * o[1]) + (o[2] * o[2] + o[3] * o[3]); }
                s += __shfl_xor(s, 16); s += __shfl_xor(s, 32);
                if (fq == 0) rowss[(size_t)row * 16 + u.pn * 4 + wc] = s;
                asm volatile("" ::: "memory"); }
    }
};
struct EpiPle {
    static constexpr bool PERM = false, AFTER_DRAIN = false, MIDK = false;
    float* xio; const bf16_t* pe; const float* rowss2; float* rowss3; int mid_t;
    __device__ __forceinline__ void mid(f32x4 (&)[2][2][4][2], const Unit&, int, int, int, int) const {}
    __device__ __forceinline__ void operator()(const f32x4 (&acc)[2][2][4][2], const Unit& u, int wr, int wc, int fr, int fq) const {
        const int col0 = u.pn * BM + wc * 32 + 4 * fq;
#pragma unroll
        for (int ai = 0; ai < 2; ++ai)
#pragma unroll
            for (int m = 0; m < 4; ++m) { const int row = u.pm * BM + ai * HALF + wr * 64 + m * 16 + fr; const size_t off = (size_t)row * 1024 + col0;
                const f32x4* rs = (const f32x4*)(rowss2 + (size_t)row * 16); const f32x4 q0 = rs[0], q1 = rs[1], q2 = rs[2], q3 = rs[3];
                const float ss = ((q0[0] + q0[1]) + (q0[2] + q0[3])) + ((q1[0] + q1[1]) + (q1[2] + q1[3])) + ((q2[0] + q2[1]) + (q2[2] + q2[3])) + ((q3[0] + q3[1]) + (q3[2] + q3[3]));
                const float rstd = __builtin_amdgcn_rsqf(ss * (1.f / 1024.f) + 1e-6f); float s = 0.f;
#pragma unroll
                for (int bj = 0; bj < 2; ++bj)
#pragma unroll
                    for (int n = 0; n < 2; ++n) { const size_t c = off + bj * HALF + n * 16; const f32x4 g = sigm4(acc[ai][bj][m][n] * rstd); const u32x2 pw = *(const u32x2*)(pe + c);
                        const f32x4 pv = (f32x4){bf_lo(pw.x), bf_hi(pw.x), bf_lo(pw.y), bf_hi(pw.y)}; const f32x4 o = *(const f32x4*)(xio + c) + g * pv;
                        *(f32x4*)(xio + c) = o; s += (o[0] * o[0] + o[1] * o[1]) + (o[2] * o[2] + o[3] * o[3]); }
                s += __shfl_xor(s, 16); s += __shfl_xor(s, 32);
                if (fq == 0) rowss3[(size_t)row * 16 + u.pn * 4 + wc] = s;
                asm volatile("" ::: "memory"); }
    }
};
struct PairOrder { StaticOrder S;
    __device__ __forceinline__ bool next(int i, Unit& u) const { Unit m; if (!S.next(i >> 1, m)) return false; u.pm = m.pm; u.pn = 28 + 2 * m.pn + (i & 1); return true; }
    __device__ __forceinline__ void a_ready(const Unit&) const {}
    __device__ __forceinline__ void done(const Unit&) const {}
};
struct ListOrder {
    int pm, pn0, cnt;
    __device__ __forceinline__ bool next(int i, Unit& u) const { if (i >= cnt) return false; u.pm = pm; u.pn = pn0 + i; return true; }
    __device__ __forceinline__ void a_ready(const Unit&) const {}
    __device__ __forceinline__ void done(const Unit&) const {}
};
template <class Epi, class Sched, bool ALIGN_EPI = false, bool SP2 = false>
__device__ __forceinline__ void gemm_phase(PG8_LAS unsigned char* lds, const Gemm g, const Sched& S, const Epi& E) {
    const int tid = threadIdx.x, wid = __builtin_amdgcn_readfirstlane(tid >> 6), lane = tid & 63, wr = wid >> 2, wc = wid & 3, fr = lane & 15, fq = lane >> 4;
    const int K = g.K, nt = K / BK;
    unsigned voffA[2], voffB[2];
#pragma unroll
    for (int i = 0; i < 2; ++i) { int R, C; stage_rc(tid * 16 + i * 8192, R, C); const int Rb = Epi::PERM ? ((R & ~31) + perm32(R & 31)) : R;
        voffA[i] = (unsigned)(R * K + C) * 2u; voffB[i] = (unsigned)(Rb * K + C) * 2u; }
    const size_t kstep = (size_t)(BK * 2);
    const size_t hstep = (size_t)HALF * K * 2;
    const size_t tstep = 2 * hstep;
    const unsigned ldsw = (unsigned)wid * 1024u;
    const int aoff = lds_byte(wr * 64 + fr, fq * 8), boff = lds_byte(wc * 32 + fr, fq * 8);
#define PG8_SA(b, h) (((b) * 2 + (h)) * HTB)
#define PG8_SB(b, h) ((4 + (b) * 2 + (h)) * HTB)
#define PG8_STAGE(bufoff, gbase, voff) do { _Pragma("unroll") for (int _i = 0; _i < 2; ++_i) \
        __builtin_amdgcn_global_load_lds((const unsigned*)((const char*)(gbase) + (voff)[_i]), (PG8_LAS unsigned*)(lds + (bufoff) + ldsw + _i * 8192), 16, 0, 0); } while (0)
#define PG8_LDA(dst, b, h) do { _Pragma("unroll") for (int m = 0; m < 4; ++m) _Pragma("unroll") for (int k = 0; k < 2; ++k) dst[m][k] = *(const PG8_LAS bf16x8*)(lds + PG8_SA(b, h) + aoff + m * 2048 + k * 1024); } while (0)
#define PG8_LDB(dst, b, h) do { _Pragma("unroll") for (int n = 0; n < 2; ++n) _Pragma("unroll") for (int k = 0; k < 2; ++k) dst[n][k] = *(const PG8_LAS bf16x8*)(lds + PG8_SB(b, h) + boff + n * 2048 + k * 1024); } while (0)
#define PG8_MMA(ai, bj, At, Bt) do { __builtin_amdgcn_s_setprio(1); _Pragma("unroll") for (int m = 0; m < 4; ++m) _Pragma("unroll") for (int n = 0; n < 2; ++n) _Pragma("unroll") for (int k = 0; k < 2; ++k) \
        acc[ai][bj][m][n] = __builtin_amdgcn_mfma_f32_16x16x32_bf16(Bt[n][k], At[m][k], acc[ai][bj][m][n], 0, 0, 0); __builtin_amdgcn_s_setprio(0); } while (0)
#define PG8_WAIT_V(n) asm volatile("s_waitcnt vmcnt(" #n ")" ::: "memory")
#define PG8_WAIT_L(n) asm volatile("s_waitcnt lgkmcnt(" #n ")" ::: "memory")
#define PG8_BAR __builtin_amdgcn_s_barrier()
#define PG8_SCHED __builtin_amdgcn_sched_barrier(0)
    Unit cur, nxt; int ui = 0;
    if (!S.next(0, cur)) return;
    f32x4 acc[2][2][4][2];
#pragma unroll
    for (int a = 0; a < 2; ++a)
#pragma unroll
        for (int b = 0; b < 2; ++b)
#pragma unroll
            for (int m = 0; m < 4; ++m)
#pragma unroll
                for (int n = 0; n < 2; ++n) acc[a][b][m][n] = (f32x4){0.f, 0.f, 0.f, 0.f};
    bf16x8 At[4][2], B0[2][2], B1[2][2];
    const char* cA = (const char*)g.A + (size_t)cur.pm * tstep; const char* cB = (const char*)g.Bt + (size_t)cur.pn * tstep;
    S.a_ready(cur);
    if constexpr (SP2) {
        PG8_STAGE(PG8_SB(0, 0), cB, voffB); PG8_STAGE(PG8_SB(0, 1), cB + hstep, voffB); PG8_STAGE(PG8_SA(0, 0), cA, voffA); PG8_STAGE(PG8_SA(0, 1), cA + hstep, voffA);
        if (wr == 1) PG8_BAR;
        PG8_WAIT_V(2); PG8_BAR;
        PG8_STAGE(PG8_SB(1, 0), cB + kstep, voffB); PG8_STAGE(PG8_SA(1, 0), cA + kstep, voffA); PG8_STAGE(PG8_SB(1, 1), cB + hstep + kstep, voffB);
        PG8_WAIT_V(6); PG8_BAR;
    } else {
        PG8_STAGE(PG8_SB(0, 0), cB, voffB); PG8_STAGE(PG8_SA(0, 0), cA, voffA); PG8_STAGE(PG8_SB(0, 1), cB + hstep, voffB); PG8_STAGE(PG8_SA(0, 1), cA + hstep, voffA);
        if (wr == 1) PG8_BAR;
        PG8_WAIT_V(4); PG8_BAR;
        PG8_STAGE(PG8_SB(1, 0), cB + kstep, voffB); PG8_STAGE(PG8_SA(1, 0), cA + kstep, voffA); PG8_STAGE(PG8_SB(1, 1), cB + hstep + kstep, voffB);
        PG8_WAIT_V(6); PG8_BAR;
    }
    for (;;) {
        const bool has_next = S.next(ui + 1, nxt);
        const char* nA = has_next ? (const char*)g.A + (size_t)nxt.pm * tstep : cA; const char* nB = has_next ? (const char*)g.Bt + (size_t)nxt.pn * tstep : cB;
        for (int t = 0; t < nt; t += 2) {
            if constexpr (Epi::MIDK) { if (t == E.mid_t) E.mid(acc, cur, wr, wc, fr, fq); }
            const bool last = (t == nt - 2);
            const char* a1 = cA + (size_t)(t + 1) * kstep;
            const char* a2 = last ? nA : cA + (size_t)(t + 2) * kstep; const char* b2 = last ? nB : cB + (size_t)(t + 2) * kstep;
            const char* a3 = a2 + kstep; const char* b3 = b2 + kstep;
            if (last && has_next) S.a_ready(nxt);
            if constexpr (SP2) {
            PG8_LDB(B0, 0, 0); PG8_LDB(B1, 0, 1); PG8_SCHED; PG8_LDA(At, 0, 0); PG8_STAGE(PG8_SA(1, 1), a1 + hstep, voffA);
            PG8_WAIT_V(8); PG8_WAIT_L(0); PG8_BAR; PG8_MMA(0, 0, At, B0); PG8_MMA(0, 1, At, B1); PG8_BAR; PG8_SCHED;
            PG8_LDA(At, 0, 1); PG8_STAGE(PG8_SB(0, 0), b2, voffB); PG8_STAGE(PG8_SB(0, 1), b2 + hstep, voffB); PG8_STAGE(PG8_SA(0, 0), a2, voffA);
            PG8_WAIT_V(8); PG8_WAIT_L(0); PG8_BAR; PG8_MMA(1, 0, At, B0); PG8_MMA(1, 1, At, B1); PG8_BAR; PG8_SCHED;
            PG8_LDB(B0, 1, 0); PG8_LDB(B1, 1, 1); PG8_SCHED; PG8_LDA(At, 1, 0); PG8_STAGE(PG8_SA(0, 1), a2 + hstep, voffA);
            PG8_WAIT_V(8); PG8_WAIT_L(0); PG8_BAR; PG8_MMA(0, 0, At, B0); PG8_MMA(0, 1, At, B1); PG8_BAR; PG8_SCHED;
            PG8_LDA(At, 1, 1); PG8_STAGE(PG8_SB(1, 0), b3, voffB); PG8_STAGE(PG8_SB(1, 1), b3 + hstep, voffB); PG8_STAGE(PG8_SA(1, 0), a3, voffA);
            PG8_WAIT_V(8); PG8_WAIT_L(0); PG8_BAR; PG8_MMA(1, 0, At, B0); PG8_MMA(1, 1, At, B1); PG8_BAR; PG8_SCHED;
            } else {
            PG8_LDB(B0, 0, 0); PG8_SCHED; PG8_LDA(At, 0, 0); PG8_STAGE(PG8_SA(1, 1), a1 + hstep, voffA);
            PG8_WAIT_L(8); PG8_BAR; PG8_WAIT_L(0); PG8_MMA(0, 0, At, B0); PG8_BAR; PG8_SCHED;
            PG8_LDB(B1, 0, 1); PG8_STAGE(PG8_SB(0, 0), b2, voffB);
            PG8_BAR; PG8_WAIT_L(0); PG8_MMA(0, 1, At, B1); PG8_BAR;
            PG8_LDA(At, 0, 1); PG8_STAGE(PG8_SA(0, 0), a2, voffA);
            PG8_BAR; PG8_WAIT_L(0); PG8_MMA(1, 0, At, B0); PG8_BAR; PG8_SCHED;
            PG8_STAGE(PG8_SB(0, 1), b2 + hstep, voffB);
            PG8_WAIT_V(6); PG8_BAR; PG8_MMA(1, 1, At, B1); PG8_BAR;
            PG8_LDB(B0, 1, 0); PG8_SCHED; PG8_LDA(At, 1, 0); PG8_STAGE(PG8_SA(0, 1), a2 + hstep, voffA);
            PG8_WAIT_L(8); PG8_BAR; PG8_WAIT_L(0); PG8_MMA(0, 0, At, B0); PG8_BAR; PG8_SCHED;
            PG8_LDB(B1, 1, 1); PG8_STAGE(PG8_SB(1, 0), b3, voffB);
            PG8_BAR; PG8_WAIT_L(0); PG8_MMA(0, 1, At, B1); PG8_BAR;
            PG8_LDA(At, 1, 1); PG8_STAGE(PG8_SA(1, 0), a3, voffA);
            PG8_BAR; PG8_WAIT_L(0); PG8_MMA(1, 0, At, B0); PG8_BAR; PG8_SCHED;
            PG8_STAGE(PG8_SB(1, 1), b3 + hstep, voffB);
            PG8_WAIT_V(6); PG8_BAR; PG8_MMA(1, 1, At, B1); PG8_BAR;
            }
        }
        if constexpr (ALIGN_EPI) { if (wr == 0) PG8_BAR; }
        if constexpr (!Epi::AFTER_DRAIN) { E(acc, cur, wr, wc, fr, fq); S.done(cur); }
        if (!has_next) break;
#pragma unroll
        for (int a = 0; a < 2; ++a)
#pragma unroll
            for (int b = 0; b < 2; ++b)
#pragma unroll
                for (int m = 0; m < 4; ++m)
#pragma unroll
                    for (int n = 0; n < 2; ++n) acc[a][b][m][n] = (f32x4){0.f, 0.f, 0.f, 0.f};
        cur = nxt; cA = nA; cB = nB; ++ui;
        if constexpr (ALIGN_EPI) { if (wr == 1) PG8_BAR; }
    }
    PG8_WAIT_V(0);
    if constexpr (!ALIGN_EPI) { if (wr == 0) PG8_BAR; }
    PG8_BAR;
    if constexpr (Epi::AFTER_DRAIN) { E.fused(acc, cur, wr, wc, fr, fq, lds, wid, lane); S.done(cur); }
#undef PG8_SA
#undef PG8_SB
#undef PG8_STAGE
#undef PG8_LDA
#undef PG8_LDB
#undef PG8_MMA
#undef PG8_WAIT_V
#undef PG8_WAIT_L
#undef PG8_BAR
#undef PG8_SCHED
}
}

constexpr int T_TOK = 16384, SEQ = 8192, DM = 1024, IN_COLS = 9232, NCHUNK = SEQ / 64;
constexpr float EPS = 1e-6f;
constexpr int NWAVES = 8, NTHREADS = 512;
constexpr size_t MiB = 1u << 20;
constexpr size_t WS_CTL = 0, CTL_ZERO_BYTES = 1 * MiB;
constexpr size_t WS_WIN = 1 * MiB;
constexpr size_t WS_GKLOW = 19 * MiB;
constexpr size_t WS_DECAY = 20 * MiB;
constexpr size_t WS_ROWSS2 = 21 * MiB;
constexpr size_t WS_QK = 22 * MiB;
constexpr size_t WS_ACAT = 54 * MiB;
constexpr size_t WS_SZA = 118 * MiB;
constexpr size_t WS_WCX = 150 * MiB;
constexpr size_t WS_US = 182 * MiB;
constexpr size_t WS_WCAT = 246 * MiB;
constexpr size_t WS_WOUT = 250 * MiB;
constexpr size_t WS_WPG = 252 * MiB;
constexpr size_t WS_WPE = 254 * MiB;
constexpr size_t WS_END = 256 * MiB;
constexpr size_t OUT_H = 0, OUT_PB = 32 * MiB, OUT_AMAT = 40 * MiB;
constexpr int RING_BYTES = 131072, LDS_BYTES = 163840, MISC_OFF = LDS_BYTES - 256;

#define LAS __attribute__((address_space(3)))
typedef unsigned short bf16_t;
typedef float f32x4 __attribute__((ext_vector_type(4)));
typedef unsigned u32x4 __attribute__((ext_vector_type(4)));
typedef unsigned u32x2 __attribute__((ext_vector_type(2)));
using pg8::cvt_pk_bf16; using pg8::bf_lo; using pg8::bf_hi;
#define LDS_WAIT() asm volatile("s_waitcnt lgkmcnt(0)" ::: "memory")
__device__ __forceinline__ float bf2f(bf16_t v) { return __uint_as_float((unsigned)v << 16); }
__device__ __forceinline__ float wave_sum(float v) {
#pragma unroll
    for (int o = 1; o < 64; o <<= 1) v += __shfl_xor(v, o);
    return v;
}

struct Params {
    const float *x, *p, *norm_mix_g, *w_in, *b_merge, *w_gk2, *b_gk, *gla_norm_g, *conv_w, *w_a, *w_c, *w_out, *norm_ple_g, *w_pg, *w_pe, *norm_final_g;
    float* out; unsigned char* ws; int ph_lo, ph_hi;
};

__device__ __forceinline__ void transpose_item(const float* src, int srcN, int col0, int k0, bf16_t* dst, int dstK, int drow0, int dk0, const float* kscale, LAS float* scr, int lane) {
#pragma unroll 8
    for (int i = 0; i < 32; ++i) { const int kk = 2 * i + (lane >> 5); float v = src[(size_t)(k0 + kk) * srcN + col0 + (lane & 31)]; if (kscale) v *= kscale[k0 + kk]; scr[kk * 33 + (lane & 31)] = v; }
    LDS_WAIT(); asm volatile("" ::: "memory");
    const int c = lane & 7;
#pragma unroll
    for (int j = 0; j < 4; ++j) { const int n = (lane >> 3) + 8 * j; const LAS float* s = scr + (8 * c) * 33 + n;
        u32x4 o; o.x = cvt_pk_bf16(s[0 * 33], s[1 * 33]); o.y = cvt_pk_bf16(s[2 * 33], s[3 * 33]); o.z = cvt_pk_bf16(s[4 * 33], s[5 * 33]); o.w = cvt_pk_bf16(s[6 * 33], s[7 * 33]);
        *(u32x4*)(dst + (size_t)(drow0 + n) * dstK + dk0 + k0 + 8 * c) = o; }
    LDS_WAIT(); asm volatile("" ::: "memory");
}
__device__ __forceinline__ int win_colmap(int np) {
    const int tile = np >> 8, r = np & 255;
    if (tile < 12) return np;
    if (tile < 20) { const int j = tile - 12; return r < 128 ? 4112 + 128 * j + r : 5136 + 128 * j + (r - 128); }
    if (tile < 28) { const int j = tile - 20; return r < 128 ? 3088 + 128 * j + r : 6160 + 128 * j + (r - 128); }
    const int j = tile - 28; return r < 128 ? 7184 + 128 * j + r : 8208 + 128 * j + (r - 128);
}
__device__ __forceinline__ void p0_prologue(const Params& P, LAS unsigned char* lds, int tid, int lane, int wave, int vcu, int G) {
    bf16_t* WIN_T = (bf16_t*)(P.ws + WS_WIN); bf16_t* WCAT_T = (bf16_t*)(P.ws + WS_WCAT); bf16_t* WOUT_T = (bf16_t*)(P.ws + WS_WOUT); bf16_t* WPG_T = (bf16_t*)(P.ws + WS_WPG); bf16_t* WPE_T = (bf16_t*)(P.ws + WS_WPE);
    bf16_t* H = (bf16_t*)((unsigned char*)P.out + OUT_H); bf16_t* PB = (bf16_t*)((unsigned char*)P.out + OUT_PB); float* GKLOW = (float*)(P.ws + WS_GKLOW);
    LAS float* scr = (LAS float*)(lds + wave * 16384);
    const int gw = vcu * NWAVES + wave, NGW = G * NWAVES;
    constexpr int I_IN = 16 * 288, I_SQ = 16 * 32, I_PE = 4 * 32, NITEMS = I_IN + 4 * I_SQ + I_PE;
    for (int it = gw; it < NITEMS; it += NGW) {
        int r = it;
        if (r < I_IN) { const int kb = r / 288, nb = r % 288; transpose_item(P.w_in, IN_COLS, win_colmap(32 * nb), 64 * kb, WIN_T, 1024, 32 * nb, 0, nullptr, scr, lane); continue; } r -= I_IN;
        const int kb = r / 32 % 16, nb = r % 32, which = r / I_SQ;
        if (which == 0) transpose_item(P.w_a, 1024, 32 * nb, 64 * kb, WCAT_T, 2048, 32 * nb, 0, nullptr, scr, lane);
        else if (which == 1) transpose_item(P.w_c, 1024, 32 * nb, 64 * kb, WCAT_T, 2048, 32 * nb, 1024, nullptr, scr, lane);
        else if (which == 2) transpose_item(P.w_out, 1024, 32 * nb, 64 * kb, WOUT_T, 1024, 32 * nb, 0, nullptr, scr, lane);
        else if (which == 3) transpose_item(P.w_pg, 1024, 32 * nb, 64 * kb, WPG_T, 1024, 32 * nb, 0, P.norm_ple_g, scr, lane);
        else { const int r2 = r - 4 * I_SQ; transpose_item(P.w_pe, 1024, 32 * (r2 % 32), 64 * (r2 / 32), WPE_T, 256, 32 * (r2 % 32), 0, nullptr, scr, lane); }
    }
    for (int e = vcu * NTHREADS + tid; e < T_TOK * 256 / 8; e += G * NTHREADS) { const f32x4 a = *(const f32x4*)(P.p + (size_t)e * 8), b = *(const f32x4*)(P.p + (size_t)e * 8 + 4);
        *(u32x4*)(PB + (size_t)e * 8) = pg8::pack8(a, b); }
    __syncthreads();
    LAS float* WgT = (LAS float*)lds;
    for (int e = tid; e < 16 * 1024; e += NTHREADS) { const int k = e >> 4, c = e & 15; WgT[c * 1024 + k] = P.w_in[(size_t)k * IN_COLS + 3072 + c]; }
    __syncthreads();
    f32x4 gv[4];
#pragma unroll
    for (int j = 0; j < 4; ++j) gv[j] = *(const f32x4*)(P.norm_mix_g + 4 * lane + 256 * j);
    for (int pr = gw; pr < T_TOK / 2; pr += NGW) {
        f32x4 hv[2][4];
#pragma unroll
        for (int r = 0; r < 2; ++r) { const float* xr = P.x + (size_t)(2 * pr + r) * DM; float ss = 0.f;
#pragma unroll
            for (int j = 0; j < 4; ++j) { hv[r][j] = *(const f32x4*)(xr + 4 * lane + 256 * j); ss += (hv[r][j][0] * hv[r][j][0] + hv[r][j][1] * hv[r][j][1]) + (hv[r][j][2] * hv[r][j][2] + hv[r][j][3] * hv[r][j][3]); }
            const float rstd = 1.0f / sqrtf(wave_sum(ss) * (1.f / DM) + EPS);
            bf16_t* hr = H + (size_t)(2 * pr + r) * DM;
#pragma unroll
            for (int j = 0; j < 4; ++j) { hv[r][j] = hv[r][j] * rstd * gv[j]; u32x2 w; w.x = cvt_pk_bf16(hv[r][j][0], hv[r][j][1]); w.y = cvt_pk_bf16(hv[r][j][2], hv[r][j][3]); *(u32x2*)(hr + 4 * lane + 256 * j) = w; } }
        float a[32];
#pragma unroll
        for (int c = 0; c < 16; ++c) { float s0 = 0.f, s1 = 0.f;
#pragma unroll
            for (int j = 0; j < 4; ++j) { const f32x4 w = *(const LAS f32x4*)(WgT + c * 1024 + 4 * lane + 256 * j);
                s0 += (hv[0][j][0] * w[0] + hv[0][j][1] * w[1]) + (hv[0][j][2] * w[2] + hv[0][j][3] * w[3]); s1 += (hv[1][j][0] * w[0] + hv[1][j][1] * w[1]) + (hv[1][j][2] * w[2] + hv[1][j][3] * w[3]); }
            a[c] = s0; a[16 + c] = s1; }
#pragma unroll
        for (int o = 32, n = 16; n >= 1; o >>= 1, n >>= 1) { const bool up = (lane & o) != 0;
#pragma unroll
            for (int i = 0; i < n; ++i) { const float send = up ? a[i] : a[i + n], keep = up ? a[i + n] : a[i]; a[i] = keep + __shfl_xor(send, o); } }
        a[0] += __shfl_xor(a[0], 1);
        if ((lane & 1) == 0) { const int idx = lane >> 1; GKLOW[(size_t)(2 * pr + (idx >> 4)) * 16 + (idx & 15)] = a[0]; }
    }
}

typedef short bf16x8 __attribute__((ext_vector_type(8)));
typedef float f32x16 __attribute__((ext_vector_type(16)));
constexpr int REC_BYTES = 43008, REC_QI = 0, REC_KDT = 16384, REC_AM = 32768, REC_DEC = 40960;
__device__ __forceinline__ int img256(int row, int col) { return row * 256 + ((((col >> 3) ^ (row & 15))) << 4) + (col & 7) * 2; }
__device__ __forceinline__ int img128(int row, int col) { return row * 128 + ((((col >> 3) ^ ((row >> 1) & 7))) << 4) + (col & 7) * 2; }
typedef float f32x2c __attribute__((ext_vector_type(2))); typedef __bf16 bf16x2c __attribute__((ext_vector_type(2)));
__device__ __forceinline__ unsigned cvt_pk_c(float lo, float hi) { const f32x2c v = {lo, hi}; const bf16x2c b = __builtin_convertvector(v, bf16x2c); return __builtin_bit_cast(unsigned, b); }
__device__ __forceinline__ bf16_t f2bf(float v) { return (bf16_t)(cvt_pk_c(v, 0.f) & 0xffffu); }
__device__ __forceinline__ bf16x8 lds_frag(LAS unsigned char* p) { return *(LAS bf16x8*)p; }

__device__ __forceinline__ void gla_prep(const Params& P, LAS unsigned char* lds, int tid, int lane, int wave, int vcu, int G) {
    const bf16_t* QK = (const bf16_t*)(P.ws + WS_QK); const float* GKLOW = (const float*)(P.ws + WS_GKLOW); unsigned char* REC = P.ws + WS_US;
    LAS float* gl = (LAS float*)lds; LAS float* tot = (LAS float*)(lds + 4096); LAS unsigned char* Qi = lds + 8192; LAS unsigned char* Ki = lds + 24576; LAS unsigned char* Am = lds + 40960;
    const int d = tid & 127, tg = tid >> 7, r32 = lane & 31, hh = lane >> 5;
    for (int u = vcu; u < 1024; u += G) {
        const int h = u & 3, n = (u >> 2) & 127, b = u >> 9, t0 = b * SEQ + n * 64;
        unsigned char* rec = REC + (size_t)u * REC_BYTES;
        for (int e = tid; e < 1024; e += NTHREADS) gl[e] = GKLOW[(size_t)t0 * 16 + e];
        float qv[16], kv[16], w2[16];
#pragma unroll
        for (int i = 0; i < 16; ++i) { const size_t t = (size_t)(t0 + 16 * tg + i); qv[i] = bf2f(QK[t * 1024 + h * 128 + d]); kv[i] = bf2f(QK[t * 1024 + 512 + h * 128 + d]); }
#pragma unroll
        for (int r = 0; r < 16; ++r) w2[r] = P.w_gk2[r * 512 + h * 128 + d];
        const float bias = P.b_gk[h * 128 + d];
        __syncthreads();
        float c[16]; float run = 0.f;
#pragma unroll
        for (int i = 0; i < 16; ++i) { float z = bias;
#pragma unroll
            for (int r4 = 0; r4 < 4; ++r4) { const f32x4 g4 = *(const LAS f32x4*)(gl + (16 * tg + i) * 16 + 4 * r4); z += (g4[0] * w2[4 * r4] + g4[1] * w2[4 * r4 + 1]) + (g4[2] * w2[4 * r4 + 2] + g4[3] * w2[4 * r4 + 3]); }
            const float gk = (fminf(z, 0.f) - __logf(1.f + __expf(-fabsf(z)))) * (1.f / 16.f); run += gk; c[i] = run; }
        tot[tg * 128 + d] = run;
        __syncthreads();
        float off = 0.f, total = 0.f;
#pragma unroll
        for (int g = 0; g < 4; ++g) { const float v = tot[g * 128 + d]; total += v; if (g < tg) off += v; }
        float kd[16];
#pragma unroll
        for (int i = 0; i < 16; ++i) { const float bb = off + c[i]; const int t = 16 * tg + i;
            *(LAS bf16_t*)(Qi + img256(t, d)) = f2bf(qv[i] * 0.08838834764831845f * __expf(bb));
            *(LAS bf16_t*)(Ki + img256(t, d)) = f2bf(kv[i] * __expf(-bb));
            kd[i] = kv[i] * __expf(total - bb); }
        {
            u32x4 w0, w1; w0.x = cvt_pk_bf16(kd[0], kd[1]); w0.y = cvt_pk_bf16(kd[2], kd[3]); w0.z = cvt_pk_bf16(kd[4], kd[5]); w0.w = cvt_pk_bf16(kd[6], kd[7]);
            w1.x = cvt_pk_bf16(kd[8], kd[9]); w1.y = cvt_pk_bf16(kd[10], kd[11]); w1.z = cvt_pk_bf16(kd[12], kd[13]); w1.w = cvt_pk_bf16(kd[14], kd[15]);
            *(u32x4*)(rec + REC_KDT + img128(d, 16 * tg)) = w0; *(u32x4*)(rec + REC_KDT + img128(d, 16 * tg + 8)) = w1; }
        if (tg == 0) ((float*)(rec + REC_DEC))[d] = __expf(total);
        __syncthreads();
        if (wave < 4) {
            const int mi = wave >> 1, nj = wave & 1, ra = 32 * mi + r32, rb = 32 * nj + r32;
            f32x16 acc;
#pragma unroll
            for (int e = 0; e < 16; ++e) acc[e] = 0.f;
#pragma unroll
            for (int s = 0; s < 8; ++s) { const bf16x8 a = lds_frag(Qi + ra * 256 + ((((2 * s + hh) ^ (ra & 15))) << 4)), bq = lds_frag(Ki + rb * 256 + ((((2 * s + hh) ^ (rb & 15))) << 4));
                acc = __builtin_amdgcn_mfma_f32_32x32x16_bf16(a, bq, acc, 0, 0, 0); }
            const int j = 32 * nj + r32;
#pragma unroll
            for (int e = 0; e < 16; ++e) { const int i = 32 * mi + (e & 3) + 8 * (e >> 2) + 4 * hh; *(LAS bf16_t*)(Am + img128(i, j)) = f2bf(j <= i ? acc[e] : 0.f); }
        }
#pragma unroll
        for (int k = 0; k < 2; ++k) { const int ch = tid + NTHREADS * k; *(u32x4*)(rec + REC_QI + ch * 16) = *(LAS u32x4*)(Qi + ch * 16); }
        __syncthreads();
        *(u32x4*)(rec + REC_AM + tid * 16) = *(LAS u32x4*)(Am + tid * 16);
        __syncthreads();
    }
}

typedef short s16x4 __attribute__((ext_vector_type(4)));
__device__ __forceinline__ s16x4 lds_tr(LAS unsigned char* p) { return __builtin_bit_cast(s16x4, __builtin_amdgcn_ds_read_tr16_b64_v4i16((LAS s16x4*)p)); }
__device__ __forceinline__ void gla_scan(const Params& P, LAS unsigned char* lds, int tid, int lane, int wave, int bh, int dvs) {
    const unsigned char* REC = P.ws + WS_US; const bf16_t* ACAT = (const bf16_t*)(P.ws + WS_ACAT); bf16_t* O = (bf16_t*)(P.ws + WS_QK);
    constexpr int BUF = 47104, B_QI = 0, B_KDT = 16384, B_AM = 32768, B_DEC = 40960, B_VT = 43008, ST0 = 3 * BUF, ST_BYTES = 8192;
    static_assert(ST0 + 2 * ST_BYTES <= MISC_OFF && REC_BYTES == 7 * 384 * 16 && B_VT == REC_BYTES, "scan LDS map");
    const int b = bh >> 2, h = bh & 3, r32 = lane & 31, hh = lane >> 5;
    const size_t ubase = ((size_t)b * 128) * 4 + h;
    const int vtid = tid - 384;
    const unsigned char* vsrc = (const unsigned char*)(ACAT + (size_t)(b * SEQ + (vtid >> 2)) * 2048 + h * 256 + dvs * 32 + (vtid & 3) * 8);
    const int vrd = B_VT + (8 * hh + ((lane & 15) >> 2)) * 64 + (16 * ((lane >> 4) & 1) + 4 * (lane & 3)) * 2;
#define SCAN_STAGE(nn, bufi) do { const unsigned char* src_ = REC + (ubase + 4 * (size_t)(nn)) * REC_BYTES; \
        _Pragma("unroll") for (int k_ = 0; k_ < 7; ++k_) __builtin_amdgcn_global_load_lds((const unsigned*)(src_ + (size_t)(k_ * 384 + tid) * 16), (LAS unsigned*)(lds + (bufi) * BUF + (k_ * 384 + wave * 64) * 16), 16, 0, 0); } while (0)
#define SCAN_VSTAGE(nn, bufi) do { const unsigned char* src_ = vsrc + (size_t)(nn) * 64 * 4096; \
        _Pragma("unroll") for (int k_ = 0; k_ < 2; ++k_) __builtin_amdgcn_global_load_lds((const unsigned*)(src_ + (size_t)k_ * 32 * 4096), (LAS unsigned*)(lds + (bufi) * BUF + B_VT + (k_ * 128 + (wave - 6) * 64) * 16), 16, 0, 0); } while (0)
#define SCAN_VFRAG(s_) __builtin_shufflevector(lds_tr(bufc + vrd + (16 * (s_)) * 64), lds_tr(bufc + vrd + (16 * (s_) + 4) * 64), 0, 1, 2, 3, 4, 5, 6, 7)
    f32x16 accS;
#pragma unroll
    for (int e = 0; e < 16; ++e) accS[e] = 0.f;
    const int kq = wave - 2;
    if (wave < 6) { SCAN_STAGE(0, 0); SCAN_STAGE(1, 1); } else { SCAN_VSTAGE(0, 0); SCAN_VSTAGE(1, 1); }
    for (int e = tid; e < ST_BYTES / 16; e += NTHREADS) *(LAS u32x4*)(lds + ST0 + e * 16) = (u32x4){0u, 0u, 0u, 0u};
    if (wave < 6) asm volatile("s_waitcnt vmcnt(7) lgkmcnt(0)" ::: "memory"); else asm volatile("s_waitcnt vmcnt(2) lgkmcnt(0)" ::: "memory");
    __builtin_amdgcn_s_barrier(); asm volatile("" ::: "memory");
    int slot = 0;
    for (int n = 0; n < 128; ++n) {
        const int cur = n & 1, s1 = (slot == 2) ? 0 : slot + 1, s2 = (s1 == 2) ? 0 : s1 + 1;
        LAS unsigned char* bufc = lds + slot * BUF; LAS unsigned char* stc = lds + ST0 + cur * ST_BYTES; LAS unsigned char* stn = lds + ST0 + (cur ^ 1) * ST_BYTES;
        if (wave < 2) {
            const int ra = 32 * wave + r32;
            f32x16 acc;
#pragma unroll
            for (int e = 0; e < 16; ++e) acc[e] = 0.f;
#pragma unroll
            for (int s = 0; s < 4; ++s) { const bf16x8 a = lds_frag(bufc + B_AM + ra * 128 + ((((2 * s + hh) ^ ((ra >> 1) & 7))) << 4)); const bf16x8 bv = SCAN_VFRAG(s);
                acc = __builtin_amdgcn_mfma_f32_32x32x16_bf16(a, bv, acc, 0, 0, 0); }
#pragma unroll
            for (int s = 0; s < 8; ++s) { const bf16x8 a = lds_frag(bufc + B_QI + ra * 256 + ((((2 * s + hh) ^ (ra & 15))) << 4)), bs = lds_frag(stc + r32 * 256 + ((((2 * s + hh) ^ (r32 & 15))) << 4));
                acc = __builtin_amdgcn_mfma_f32_32x32x16_bf16(a, bs, acc, 0, 0, 0); }
            bf16_t* orow = O + (size_t)(b * SEQ + n * 64 + 32 * wave + 4 * hh) * 1024 + h * 256 + dvs * 32 + r32;
#pragma unroll
            for (int e = 0; e < 16; ++e) orow[(size_t)((e & 3) + 8 * (e >> 2)) * 1024] = f2bf(acc[e]);
        } else if (wave < 6) {
            const int ra = 32 * kq + r32;
#pragma unroll
            for (int g = 0; g < 4; ++g) { const f32x4 dc = *(const LAS f32x4*)(bufc + B_DEC + (32 * kq + 8 * g + 4 * hh) * 4);
#pragma unroll
                for (int e = 0; e < 4; ++e) accS[4 * g + e] *= dc[e]; }
#pragma unroll
            for (int s = 0; s < 4; ++s) { const bf16x8 a = lds_frag(bufc + B_KDT + ra * 128 + ((((2 * s + hh) ^ ((ra >> 1) & 7))) << 4)); const bf16x8 bv = SCAN_VFRAG(s);
                accS = __builtin_amdgcn_mfma_f32_32x32x16_bf16(a, bv, accS, 0, 0, 0); }
#pragma unroll
            for (int g = 0; g < 4; ++g) { u32x2 w; w.x = cvt_pk_c(accS[4 * g], accS[4 * g + 1]); w.y = cvt_pk_c(accS[4 * g + 2], accS[4 * g + 3]);
                *(LAS u32x2*)(stn + r32 * 256 + ((((4 * kq + g) ^ (r32 & 15))) << 4) + 8 * hh) = w; }
        }
        if (wave < 6) {
            if (n + 2 < 128) { SCAN_STAGE(n + 2, s2); asm volatile("s_waitcnt vmcnt(7) lgkmcnt(0)" ::: "memory"); }
            else asm volatile("s_waitcnt vmcnt(0) lgkmcnt(0)" ::: "memory");
        } else {
            if (n + 2 < 128) { SCAN_VSTAGE(n + 2, s2); asm volatile("s_waitcnt vmcnt(2) lgkmcnt(0)" ::: "memory"); }
            else asm volatile("s_waitcnt vmcnt(0) lgkmcnt(0)" ::: "memory");
        }
        __builtin_amdgcn_s_barrier(); asm volatile("" ::: "memory");
        slot = s1;
    }
    asm volatile("s_waitcnt vmcnt(0) lgkmcnt(0)" ::: "memory"); __syncthreads();
#undef SCAN_STAGE
#undef SCAN_VSTAGE
#undef SCAN_VFRAG
}

__device__ __forceinline__ void gla_fin(const Params& P, int lane, int gw, int NGW) {
    const bf16_t* O = (const bf16_t*)(P.ws + WS_QK); const bf16_t* SZA = (const bf16_t*)(P.ws + WS_SZA); const bf16_t* WCX = (const bf16_t*)(P.ws + WS_WCX); bf16_t* ACAT = (bf16_t*)(P.ws + WS_ACAT);
    f32x4 gn[2]; gn[0] = *(const f32x4*)(P.gla_norm_g + ((8 * lane) & 255)); gn[1] = *(const f32x4*)(P.gla_norm_g + ((8 * lane) & 255) + 4);
    f32x4 cw[2][3][2];
#pragma unroll
    for (int j = 0; j < 2; ++j)
#pragma unroll
        for (int k = 0; k < 3; ++k) { cw[j][k][0] = *(const f32x4*)(P.conv_w + k * 1024 + 512 * j + 8 * lane); cw[j][k][1] = *(const f32x4*)(P.conv_w + k * 1024 + 512 * j + 8 * lane + 4); }
    for (int t = gw; t < T_TOK; t += NGW) {
        const int tl = t & (SEQ - 1);
#pragma unroll
        for (int j = 0; j < 2; ++j) {
            const size_t c0 = (size_t)512 * j + 8 * lane;
            f32x4 o0, o1, z0, z1; pg8::unpack8(*(const u32x4*)(O + (size_t)t * 1024 + c0), o0, o1); pg8::unpack8(*(const u32x4*)(SZA + (size_t)t * 1024 + c0), z0, z1);
            float ss = ((o0[0] * o0[0] + o0[1] * o0[1]) + (o0[2] * o0[2] + o0[3] * o0[3])) + ((o1[0] * o1[0] + o1[1] * o1[1]) + (o1[2] * o1[2] + o1[3] * o1[3]));
#pragma unroll
            for (int m = 1; m < 32; m <<= 1) ss += __shfl_xor(ss, m);
            const float rstd = 1.0f / sqrtf(ss * (1.f / 256.f) + EPS);
            *(u32x4*)(ACAT + (size_t)t * 2048 + c0) = pg8::pack8(o0 * rstd * gn[0] * z0, o1 * rstd * gn[1] * z1);
            f32x4 g0, g1, a0, a1, b0, b1, c0v, c1v; pg8::unpack8(*(const u32x4*)(ACAT + (size_t)t * 2048 + 1024 + c0), g0, g1);
            pg8::unpack8(*(const u32x4*)(WCX + (size_t)t * 1024 + c0), c0v, c1v);
            if (tl >= 1) pg8::unpack8(*(const u32x4*)(WCX + (size_t)(t - 1) * 1024 + c0), b0, b1); else { b0 = (f32x4){0.f, 0.f, 0.f, 0.f}; b1 = b0; }
            if (tl >= 2) pg8::unpack8(*(const u32x4*)(WCX + (size_t)(t - 2) * 1024 + c0), a0, a1); else { a0 = (f32x4){0.f, 0.f, 0.f, 0.f}; a1 = a0; }
            const f32x4 u0 = cw[j][0][0] * a0 + cw[j][1][0] * b0 + cw[j][2][0] * c0v, u1 = cw[j][0][1] * a1 + cw[j][1][1] * b1 + cw[j][2][1] * c1v;
            *(u32x4*)(ACAT + (size_t)t * 2048 + 1024 + c0) = pg8::pack8(g0 * u0, g1 * u1);
        }
    }
}

__device__ __forceinline__ void final_norm(const Params& P, int lane, int gw, int NGW) {
    const float* RS3 = (const float*)(P.ws + WS_GKLOW);
    f32x4 gv[4];
#pragma unroll
    for (int j = 0; j < 4; ++j) gv[j] = *(const f32x4*)(P.norm_final_g + 4 * lane + 256 * j);
    for (int row = gw; row < T_TOK; row += NGW) {
        const f32x4* rs = (const f32x4*)(RS3 + (size_t)row * 16); const f32x4 q0 = rs[0], q1 = rs[1], q2 = rs[2], q3 = rs[3];
        const float ss = ((q0[0] + q0[1]) + (q0[2] + q0[3])) + ((q1[0] + q1[1]) + (q1[2] + q1[3])) + ((q2[0] + q2[1]) + (q2[2] + q2[3])) + ((q3[0] + q3[1]) + (q3[2] + q3[3]));
        const float rstd = 1.0f / sqrtf(ss * (1.f / DM) + EPS);
        float* o = P.out + (size_t)row * DM;
#pragma unroll
        for (int j = 0; j < 4; ++j) { const f32x4 v = *(const f32x4*)(o + 4 * lane + 256 * j); *(f32x4*)(o + 4 * lane + 256 * j) = v * rstd * gv[j]; }
    }
}

#define RLX_AGENT __ATOMIC_RELAXED, __HIP_MEMORY_SCOPE_AGENT
#define XB_TMO      128
#define XB_XCNT(j)  (256  + 64 * (j))
#define XB_XSUB(j)  (1280 + 64 * (j))
#define XB_XGEN(j)  (2304 + 64 * (j))
#define XB_TOP      3328
#define XB_TOPGEN   3392
#define XCD_BAR_WORDS 3456
#define XB_SPIN_CAP (1u << 18)

__device__ __forceinline__ unsigned xb_ld(unsigned* p)              { return __hip_atomic_load(p, __ATOMIC_RELAXED, __HIP_MEMORY_SCOPE_AGENT); }
__device__ __forceinline__ unsigned xb_add(unsigned* p, unsigned v) { return __hip_atomic_fetch_add(p, v, __ATOMIC_RELAXED, __HIP_MEMORY_SCOPE_AGENT); }
__device__ __forceinline__ unsigned xb_xcc_id() { return (unsigned)__builtin_amdgcn_s_getreg((3 << 11) | 20) & 0xFu; }
#define XB_SPIN(cond, bar) do { unsigned _sp = 0; while (cond) { __builtin_amdgcn_s_sleep(1); \
    if ((++_sp & 255u) == 0u) { if (xb_ld(&(bar)[XB_TMO])) break; if (_sp > XB_SPIN_CAP) { atomicAdd(&(bar)[XB_TMO], 1u); break; } } } } while (0)

struct XcdBarrier {
    unsigned* bar; unsigned x;
    volatile LAS unsigned* st;
};

__device__ __forceinline__ XcdBarrier xcd_barrier_post(unsigned* bar, volatile LAS unsigned* st) {
    XcdBarrier b; b.bar = bar; b.x = xb_xcc_id(); b.st = st;
    if (threadIdx.x == 0) (void)xb_add(&bar[XB_XCNT(b.x)], 1u);
    return b;
}
__device__ __forceinline__ void xcd_barrier_complete(unsigned* bar, unsigned x, unsigned& nloc, unsigned& nx) {
    const unsigned G = gridDim.x * gridDim.y * gridDim.z;
    unsigned sum, cnt, mine, sp = 0u;
    for (;;) {
        sum = 0u; cnt = 0u; mine = 0u;
#pragma unroll
        for (unsigned j = 0; j < 16; ++j) { const unsigned c = xb_ld(&bar[XB_XCNT(j)]); sum += c; cnt += (c > 0u) ? 1u : 0u; mine = (j == x) ? c : mine; }
        if (sum == G) break;
        __builtin_amdgcn_s_sleep(1);
        if ((++sp & 255u) == 0u) { if (xb_ld(&bar[XB_TMO])) break; if (sp > XB_SPIN_CAP) { atomicAdd(&bar[XB_TMO], 1u); break; } }
    }
    nloc = mine > 0u ? mine : 1u; nx = cnt > 0u ? cnt : 1u;
}

__device__ __forceinline__ void xcd_barrier(const XcdBarrier& b) {
    asm volatile("s_waitcnt vmcnt(0)" ::: "memory");
    __syncthreads();
    if (threadIdx.x == 0) {
        unsigned* bar = b.bar;
        __builtin_amdgcn_s_waitcnt(0);
        unsigned nloc = b.st[0], nx = b.st[1];
        if (nloc == 0u) { xcd_barrier_complete(bar, b.x, nloc, nx); b.st[0] = nloc; b.st[1] = nx; }
        const unsigned old = xb_add(&bar[XB_XSUB(b.x)], 1u);
        const unsigned gen = old / nloc;
        if (old + 1u == (gen + 1u) * nloc) {
            __builtin_amdgcn_fence(__ATOMIC_RELEASE, "agent");
            asm volatile("s_waitcnt vmcnt(0)" ::: "memory");
            const unsigned og = xb_add(&bar[XB_TOP], 1u);
            const unsigned tg = og / nx;
            if (og + 1u == (tg + 1u) * nx) xb_add(&bar[XB_TOPGEN], 1u);
            else XB_SPIN(xb_ld(&bar[XB_TOPGEN]) == tg, bar);
            __builtin_amdgcn_fence(__ATOMIC_ACQUIRE, "agent");
            xb_add(&bar[XB_XGEN(b.x)], 1u);
            asm volatile("s_waitcnt vmcnt(0)" ::: "memory");
        } else {
            XB_SPIN(xb_ld(&bar[XB_XGEN(b.x)]) == gen, bar);
            __builtin_amdgcn_fence(__ATOMIC_ACQUIRE, "agent");
            asm volatile("s_waitcnt vmcnt(0)" ::: "memory");
        }
    }
    __syncthreads();
}


constexpr int N_PHASES = 9;
#ifndef SKIPMASK
#define SKIPMASK 0
#endif
#ifndef DUP_PHASE
#define DUP_PHASE -1
#endif
#ifndef MK_N_LAUNCHES
#define MK_N_LAUNCHES 1
#endif
__global__ void __launch_bounds__(NTHREADS, 2) mk_fwd(Params P) {
    extern __shared__ __attribute__((aligned(16))) unsigned char lds_raw[];
    LAS unsigned char* lds = (LAS unsigned char*)lds_raw;
    const int tid = threadIdx.x, lane = tid & 63, wave = __builtin_amdgcn_readfirstlane(tid >> 6);
    const int G = gridDim.x, bx = blockIdx.x, vcu = (G % 8 == 0) ? (bx % 8) * (G / 8) + bx / 8 : bx;
    const int lo = P.ph_lo, hi = P.ph_hi;
    if (tid < 64) ((LAS unsigned*)(lds + MISC_OFF))[tid] = 0u;
    __syncthreads();
    XcdBarrier bar = xcd_barrier_post((unsigned*)(P.ws + WS_CTL) + 1024, (volatile LAS unsigned*)(lds + MISC_OFF) + 8);
#define IN(k) (lo <= (k) && (k) < hi)
#define SEAM(k) do { if (IN(k) && IN((k) + 1)) xcd_barrier(bar); } while (0)
    bf16_t* WIN_T = (bf16_t*)(P.ws + WS_WIN); bf16_t* WCAT_T = (bf16_t*)(P.ws + WS_WCAT); bf16_t* WOUT_T = (bf16_t*)(P.ws + WS_WOUT); bf16_t* WPG_T = (bf16_t*)(P.ws + WS_WPG); bf16_t* WPE_T = (bf16_t*)(P.ws + WS_WPE);
    bf16_t* H = (bf16_t*)((unsigned char*)P.out + OUT_H); bf16_t* PB = (bf16_t*)((unsigned char*)P.out + OUT_PB);
    bf16_t* QK = (bf16_t*)(P.ws + WS_QK); bf16_t* ACAT = (bf16_t*)(P.ws + WS_ACAT); bf16_t* SZA = (bf16_t*)(P.ws + WS_SZA); bf16_t* WCX = (bf16_t*)(P.ws + WS_WCX);
    bf16_t* RB = (bf16_t*)(P.ws + WS_US); bf16_t* SGC = RB + (size_t)T_TOK * 1024; bf16_t* MERGED = SZA; bf16_t* PE = WCX; bf16_t* X2B = QK;
    float* ROWSS2 = (float*)(P.ws + WS_ROWSS2); float* ROWSS3 = (float*)(P.ws + WS_GKLOW);

    for (int rep_ = 0; rep_ < (DUP_PHASE == 0 ? 2 : 1); ++rep_) { if (rep_) xcd_barrier(bar);
    if (IN(0) && !(SKIPMASK & 1)) { p0_prologue(P, lds, tid, lane, wave, vcu, G); }
    }
    SEAM(0);
    for (int rep_ = 0; rep_ < (DUP_PHASE == 1 ? 2 : 1); ++rep_) { if (rep_) xcd_barrier(bar);
    if (IN(1) && !(SKIPMASK & 2)) {
        pg8::Gemm g{H, WIN_T, T_TOK, 7168, 1024}; pg8::StaticOrder S; S.init(T_TOK, 7168, G, bx);
        pg8::EpiIn E{QK, ACAT, SZA, WCX, RB, SGC, P.b_merge, -1};
        pg8::gemm_phase<pg8::EpiIn, pg8::StaticOrder, true, true>(lds, g, S, E);
    }
    }
    SEAM(1);
    for (int rep_ = 0; rep_ < (DUP_PHASE == 2 ? 2 : 1); ++rep_) { if (rep_) xcd_barrier(bar);
    if (IN(2) && !(SKIPMASK & 4)) { gla_prep(P, lds, tid, lane, wave, vcu, G); }
    }
    SEAM(2);
    for (int rep_ = 0; rep_ < (DUP_PHASE == 3 ? 2 : 1); ++rep_) { if (rep_) xcd_barrier(bar);
    if (IN(3) && !(SKIPMASK & 8)) { if (bx < 64) gla_scan(P, lds, tid, lane, wave, bx & 7, bx >> 3); }
    }
    SEAM(3);
    for (int rep_ = 0; rep_ < (DUP_PHASE == 4 ? 2 : 1); ++rep_) { if (rep_) xcd_barrier(bar);
    if (IN(4) && !(SKIPMASK & 16)) { gla_fin(P, lane, vcu * NWAVES + wave, G * NWAVES); }
    }
    SEAM(4);
    for (int rep_ = 0; rep_ < (DUP_PHASE == 5 ? 2 : 1); ++rep_) { if (rep_) xcd_barrier(bar);
    if (IN(5) && !(SKIPMASK & 32)) {
        { pg8::Gemm g{H, WIN_T, T_TOK, 9216, 1024}; pg8::PairOrder L; L.S.init(T_TOK, 1024, G, bx); pg8::EpiIn E{QK, ACAT, SZA, WCX, RB, SGC, P.b_merge, -1};
          pg8::gemm_phase<pg8::EpiIn, pg8::PairOrder, true, true>(lds, g, L, E); }
        { pg8::Gemm g{PB, WPE_T, T_TOK, 1024, 256}; pg8::StaticOrder S; S.init(T_TOK, 1024, G, bx); pg8::EpiPlain E{PE, 1024, -1};
          pg8::gemm_phase<pg8::EpiPlain, pg8::StaticOrder, false, true>(lds, g, S, E); }
        { pg8::Gemm g{ACAT, WCAT_T, T_TOK, 1024, 2048}; pg8::StaticOrder S; S.init(T_TOK, 1024, G, bx); pg8::EpiMerge E{RB, SGC, MERGED, 16};
          pg8::gemm_phase<pg8::EpiMerge, pg8::StaticOrder, false, true>(lds, g, S, E); }
    }
    }
    SEAM(5);
    for (int rep_ = 0; rep_ < (DUP_PHASE == 6 ? 2 : 1); ++rep_) { if (rep_) xcd_barrier(bar);
    if (IN(6) && !(SKIPMASK & 64)) {
        pg8::Gemm g{MERGED, WOUT_T, T_TOK, 1024, 1024}; pg8::StaticOrder S; S.init(T_TOK, 1024, G, bx);
        pg8::EpiOut E{P.x, P.out, X2B, ROWSS2, -1};
        pg8::gemm_phase<pg8::EpiOut, pg8::StaticOrder, false, true>(lds, g, S, E);
    }
    }
    SEAM(6);
    for (int rep_ = 0; rep_ < (DUP_PHASE == 7 ? 2 : 1); ++rep_) { if (rep_) xcd_barrier(bar);
    if (IN(7) && !(SKIPMASK & 128)) {
        pg8::Gemm g{X2B, WPG_T, T_TOK, 1024, 1024}; pg8::StaticOrder S; S.init(T_TOK, 1024, G, bx);
        pg8::EpiPle E{P.out, PE, ROWSS2, ROWSS3, -1};
        pg8::gemm_phase<pg8::EpiPle, pg8::StaticOrder, false, true>(lds, g, S, E);
    }
    }
    SEAM(7);
    for (int rep_ = 0; rep_ < (DUP_PHASE == 8 ? 2 : 1); ++rep_) { if (rep_) xcd_barrier(bar);
    if (IN(8) && !(SKIPMASK & 256)) { final_norm(P, lane, vcu * NWAVES + wave, G * NWAVES); }
    }
#undef IN
#undef SEAM
}

extern "C" void kernel_launch(void* const* d_in, const int* in_sizes, int n_in, void* d_out, int out_size, void* d_ws, size_t ws_size, hipStream_t stream) {
    static int grid = 0;
    if (grid == 0) {
        if (n_in != 16 || in_sizes[0] != T_TOK * DM || out_size != T_TOK * DM || ws_size < WS_END) { fprintf(stderr, "kernel_launch: unexpected shapes (n_in %d, in0 %d, out %d, ws %zu)\n", n_in, n_in > 0 ? in_sizes[0] : -1, out_size, ws_size); grid = -1; return; }
        int dev = 0, cus = 0, per_cu = 0;
        if (hipGetDevice(&dev) != hipSuccess || hipDeviceGetAttribute(&cus, hipDeviceAttributeMultiprocessorCount, dev) != hipSuccess) { grid = -1; return; }
        if (hipFuncSetAttribute((const void*)mk_fwd, hipFuncAttributeMaxDynamicSharedMemorySize, LDS_BYTES) != hipSuccess) { fprintf(stderr, "kernel_launch: hipFuncSetAttribute failed\n"); grid = -1; return; }
        if (hipOccupancyMaxActiveBlocksPerMultiprocessor(&per_cu, (const void*)mk_fwd, NTHREADS, LDS_BYTES) != hipSuccess || per_cu < 1) { fprintf(stderr, "kernel_launch: occupancy query says %d\n", per_cu); per_cu = 1; }
        (void)hipGetLastError();
        grid = cus;
    }
    if (grid < 0) return;
    if (hipMemsetAsync((char*)d_ws + WS_CTL, 0, 65536, stream) != hipSuccess) { fprintf(stderr, "kernel_launch: hipMemsetAsync failed\n"); return; }
    Params p{};
    const float** dst = (const float**)&p;
    for (int i = 0; i < 16; ++i) dst[i] = (const float*)d_in[i];
    p.out = (float*)d_out; p.ws = (unsigned char*)d_ws;
#if MK_N_LAUNCHES == 1
    p.ph_lo = 0; p.ph_hi = N_PHASES;
    void* args[] = {&p};
    hipError_t e = hipLaunchCooperativeKernel((const void*)mk_fwd, dim3(grid), dim3(NTHREADS), args, LDS_BYTES, stream);
    if (e != hipSuccess) fprintf(stderr, "kernel_launch: cooperative launch failed: %s (grid %d)\n", hipGetErrorString(e), grid);
#else
    for (int ph = 0; ph < N_PHASES; ++ph) { p.ph_lo = ph; p.ph_hi = ph + 1; hipLaunchKernelGGL(mk_fwd, dim3(grid), dim3(NTHREADS), LDS_BYTES, stream, p); }
#endif
}
```

```cpp
#include <hip/hip_runtime.h>
#include <cstdio>
#include <cstdint>
#ifndef PROBE_REP_G1A
#define PROBE_REP_G1A 0
#endif
#ifndef PROBE_REP_PREP
#define PROBE_REP_PREP 0
#endif
#ifndef PROBE_REP_P5
#define PROBE_REP_P5 0
#endif
#ifndef PROBE_REP_P6
#define PROBE_REP_P6 0
#endif
#ifndef PROBE_REP_P0
#define PROBE_REP_P0 0
#endif
#ifndef PROBE_TS
#define PROBE_TS -1
#endif
#ifndef PROBE_REP_P8
#define PROBE_REP_P8 0
#endif
namespace pg8 {
#define PG8_LAS __attribute__((address_space(3)))
typedef unsigned short bf16_t;
typedef short bf16x8 __attribute__((ext_vector_type(8)));
typedef float f32x4 __attribute__((ext_vector_type(4)));
typedef unsigned u32x4 __attribute__((ext_vector_type(4)));
constexpr int BM = 256, BK = 64, HALF = 128, HTB = HALF * BK * 2  , STAGE_BYTES = 8 * HTB, NXCD = 8, WGM = 8;

__host__ __device__ __forceinline__ int lds_byte(int r, int c) { const int st = (r >> 4) * 2 + (c >> 5), rr = r & 15, cc = c & 31, ob = rr * 64 + cc * 2; return st * 1024 + (ob ^ (((ob >> 9) & 1) << 5)); }
__host__ __device__ __forceinline__ void stage_rc(int b, int& R, int& C) { const int st = b / 1024, sb = b % 1024, swz = sb ^ (((sb >> 9) & 1) << 5); R = (st >> 1) * 16 + swz / 64; C = (st & 1) * 32 + (swz % 64) / 2; }
__host__ __device__ __forceinline__ int perm32(int rho) { const int n = rho >> 4, i = rho & 15; return 8 * (i >> 2) + 4 * n + (i & 3); }

struct Unit { int pm, pn; };
struct Gemm { const bf16_t* A; const bf16_t* Bt; int M, N, K; };

struct StaticOrder {
    int nM, nN, nwg, G, c; int rsh = 0;
    __host__ __device__ void init(int M, int N, int G_, int c_) { nM = M / BM; nN = N / BM; nwg = nM * nN; G = G_; c = c_; }
    __host__ __device__ bool next(int i, Unit& u) const {
        const long L = (long)(i >> rsh) * G + c; if (L >= nwg) return false;
        int wgid = (int)L; { const int q = nwg / NXCD, r = nwg % NXCD, xcd = wgid % NXCD, off = wgid / NXCD; wgid = (xcd < r ? xcd * (q + 1) : r * (q + 1) + (xcd - r) * q) + off; }
        const int nig = WGM * nN, gid = wgid / nig, fm = gid * WGM, gsz = (nM - fm) < WGM ? (nM - fm) : WGM;
        u.pm = fm + ((wgid % nig) % gsz); u.pn = (wgid % nig) / gsz; return true;
    }
    __device__ __forceinline__ void a_ready(const Unit&) const {}
    __device__ __forceinline__ void done(const Unit&) const {}
};

__device__ __forceinline__ unsigned cvt_pk_bf16(float lo, float hi) { unsigned r; asm volatile("v_cvt_pk_bf16_f32 %0, %1, %2" : "=v"(r) : "v"(lo), "v"(hi)); return r; }
typedef float f32x2 __attribute__((ext_vector_type(2)));
typedef unsigned u32x2 __attribute__((ext_vector_type(2)));
__device__ __forceinline__ float bf_lo(unsigned w) { return __uint_as_float(w << 16); }
__device__ __forceinline__ float bf_hi(unsigned w) { return __uint_as_float(w & 0xffff0000u); }
__device__ __forceinline__ float fsigmoid(float v) { return __builtin_amdgcn_rcpf(1.f + __expf(-v)); }
__device__ __forceinline__ float fsilu(float v) { return v * __builtin_amdgcn_rcpf(1.f + __expf(-v)); }
__device__ __forceinline__ u32x4 pack8(const f32x4 a, const f32x4 b) { u32x4 w; w.x = cvt_pk_bf16(a[0], a[1]); w.y = cvt_pk_bf16(a[2], a[3]); w.z = cvt_pk_bf16(b[0], b[1]); w.w = cvt_pk_bf16(b[2], b[3]); return w; }
__device__ __forceinline__ void unpack8(const u32x4 w, f32x4& a, f32x4& b) { a = (f32x4){bf_lo(w.x), bf_hi(w.x), bf_lo(w.y), bf_hi(w.y)}; b = (f32x4){bf_lo(w.z), bf_hi(w.z), bf_lo(w.w), bf_hi(w.w)}; }
__device__ __forceinline__ f32x4 silu4(f32x4 v) { return (f32x4){fsilu(v[0]), fsilu(v[1]), fsilu(v[2]), fsilu(v[3])}; }
__device__ __forceinline__ f32x4 sigm4(f32x4 v) { return (f32x4){fsigmoid(v[0]), fsigmoid(v[1]), fsigmoid(v[2]), fsigmoid(v[3])}; }

struct EpiIn {
    static constexpr bool PERM = true, AFTER_DRAIN = false, MIDK = false;
    bf16_t *QK, *ACAT, *SZA, *WCX, *R, *SGC, *SGC_HI; const float* b_merge; int mid_t;
    __device__ __forceinline__ void mid(f32x4 (&)[2][2][4][2], const Unit&, int, int, int, int) const {}
    __device__ __forceinline__ void operator()(const f32x4 (&acc)[2][2][4][2], const Unit& u, int wr, int wc, int fr, int fq) const {
        const int pn = u.pn, row0 = u.pm * BM + wr * 64 + fr, c8 = wc * 32 + 8 * fq;
        __builtin_amdgcn_sched_barrier(0); asm volatile("s_nop 15\n\ts_nop 15\n\ts_nop 15\n\ts_nop 15" ::: "memory"); __builtin_amdgcn_sched_barrier(0);
        if (pn < 12) {
            bf16_t* base; int ldc, colt; const bool act = pn >= 8;
            if (pn < 4) { base = QK; ldc = 1024; colt = pn * 256; } else if (pn < 8) { base = ACAT; ldc = 2048; colt = (pn - 4) * 256; } else { base = SZA; ldc = 1024; colt = (pn - 8) * 256; }
#pragma unroll
            for (int ai = 0; ai < 2; ++ai)
#pragma unroll
                for (int m = 0; m < 4; ++m) { bf16_t* rowp = base + (size_t)(row0 + ai * HALF + m * 16) * ldc + colt + c8;
#pragma unroll
                    for (int bj = 0; bj < 2; ++bj) { f32x4 v0 = acc[ai][bj][m][0], v1 = acc[ai][bj][m][1]; if (act) { v0 = silu4(v0); v1 = silu4(v1); }
                        *(u32x4*)(rowp + bj * HALF) = pack8(v0, v1); } }
        } else if (pn < 28) {
            const bool isw = pn < 20; const int j = isw ? pn - 12 : pn - 20; bf16_t* base = isw ? WCX : ACAT + 1024; const int ldc = isw ? 1024 : 2048;
#pragma unroll
            for (int ai = 0; ai < 2; ++ai)
#pragma unroll
                for (int m = 0; m < 4; ++m) { bf16_t* rowp = base + (size_t)(row0 + ai * HALF + m * 16) * ldc + j * HALF + c8;
                    f32x4 b0 = acc[ai][1][m][0], b1 = acc[ai][1][m][1]; if (!isw) { b0 = silu4(b0); b1 = silu4(b1); }
                    *(u32x4*)rowp = pack8(acc[ai][0][m][0] * b0, acc[ai][0][m][1] * b1); }
        } else {
            const int j = pn - 28, ch = j * HALF + c8;
            const f32x4 ba0 = *(const f32x4*)(b_merge + ch), ba1 = *(const f32x4*)(b_merge + ch + 4), bc0 = *(const f32x4*)(b_merge + 1024 + ch), bc1 = *(const f32x4*)(b_merge + 1024 + ch + 4);
#pragma unroll
            for (int ai = 0; ai < 2; ++ai)
#pragma unroll
                for (int m = 0; m < 4; ++m) { const size_t off = (size_t)(row0 + ai * HALF + m * 16) * 1024 + ch;
                    const f32x4 sa0 = sigm4(acc[ai][0][m][0] + ba0), sa1 = sigm4(acc[ai][0][m][1] + ba1), sc0 = sigm4(acc[ai][1][m][0] + bc0), sc1 = sigm4(acc[ai][1][m][1] + bc1);
                    f32x4 r0, r1;
#pragma unroll
                    for (int e = 0; e < 4; ++e) { r0[e] = sa0[e] * __builtin_amdgcn_rcpf(sc0[e]); r1[e] = sa1[e] * __builtin_amdgcn_rcpf(sc1[e]); }
                    *(u32x4*)(R + off) = pack8(r0, r1); *(u32x4*)((u.pm < 48 ? SGC : SGC_HI) + off) = pack8(sc0, sc1); }
        }
    }
};
struct EpiPlain {
    static constexpr bool PERM = true, AFTER_DRAIN = false, MIDK = false;
    bf16_t* O; int ldc; int mid_t;
    __device__ __forceinline__ void mid(f32x4 (&)[2][2][4][2], const Unit&, int, int, int, int) const {}
    __device__ __forceinline__ void operator()(const f32x4 (&acc)[2][2][4][2], const Unit& u, int wr, int wc, int fr, int fq) const {
        const int row0 = u.pm * BM + wr * 64 + fr, col0 = u.pn * BM + wc * 32 + 8 * fq;
        __builtin_amdgcn_sched_barrier(0); asm volatile("s_nop 15\n\ts_nop 15\n\ts_nop 15\n\ts_nop 15" ::: "memory"); __builtin_amdgcn_sched_barrier(0);
#pragma unroll
        for (int ai = 0; ai < 2; ++ai)
#pragma unroll
            for (int m = 0; m < 4; ++m) { bf16_t* rowp = O + (size_t)(row0 + ai * HALF + m * 16) * ldc + col0;
#pragma unroll
                for (int bj = 0; bj < 2; ++bj) *(u32x4*)(rowp + bj * HALF) = pack8(acc[ai][bj][m][0], acc[ai][bj][m][1]); }
    }
};
struct EpiMerge {
    static constexpr bool PERM = true, AFTER_DRAIN = false, MIDK = true;
    const bf16_t *R, *SGC, *SGC_HI; bf16_t* O; int mid_t;
    __device__ __forceinline__ void mid(f32x4 (&acc)[2][2][4][2], const Unit& u, int wr, int wc, int fr, int fq) const {
        int row0 = u.pm * BM + wr * 64 + fr, col0 = u.pn * BM + wc * 32 + 8 * fq; asm volatile("" : "+v"(row0), "+v"(col0));
#pragma unroll
        for (int ai = 0; ai < 2; ++ai)
#pragma unroll
            for (int m = 0; m < 4; ++m) { const bf16_t* rowp = R + (size_t)(row0 + ai * HALF + m * 16) * 1024 + col0;
#pragma unroll
                for (int bj = 0; bj < 2; ++bj) { f32x4 r0, r1; unpack8(*(const u32x4*)(rowp + bj * HALF), r0, r1); acc[ai][bj][m][0] *= r0; acc[ai][bj][m][1] *= r1; }
                if (m & 1) asm volatile("" ::: "memory"); }
    }
    __device__ __forceinline__ void operator()(const f32x4 (&acc)[2][2][4][2], const Unit& u, int wr, int wc, int fr, int fq) const {
        const int row0 = u.pm * BM + wr * 64 + fr, col0 = u.pn * BM + wc * 32 + 8 * fq;
#pragma unroll
        for (int ai = 0; ai < 2; ++ai)
#pragma unroll
            for (int m = 0; m < 4; ++m) { const size_t off = (size_t)(row0 + ai * HALF + m * 16) * 1024 + col0;
#pragma unroll
                for (int bj = 0; bj < 2; ++bj) { f32x4 s0, s1; unpack8(*(const u32x4*)((u.pm < 48 ? SGC : SGC_HI) + off + bj * HALF), s0, s1);
                    *(u32x4*)(O + off + bj * HALF) = pack8(acc[ai][bj][m][0] * s0, acc[ai][bj][m][1] * s1); }
                if (m & 1) asm volatile("" ::: "memory"); }
    }
};
struct EpiOut {
    static constexpr bool PERM = false, AFTER_DRAIN = false, MIDK = false;
    const float* x; float* x2; bf16_t* x2b; float* rowss; int mid_t;
    __device__ __forceinline__ void mid(f32x4 (&)[2][2][4][2], const Unit&, int, int, int, int) const {}
    __device__ __forceinline__ void operator()(const f32x4 (&acc)[2][2][4][2], const Unit& u, int wr, int wc, int fr, int fq) const {
        const int col0 = u.pn * BM + wc * 32 + 4 * fq;
#pragma unroll
        for (int ai = 0; ai < 2; ++ai)
#pragma unroll
            for (int m = 0; m < 4; ++m) { const int row = u.pm * BM + ai * HALF + wr * 64 + m * 16 + fr; const size_t off = (size_t)row * 1024 + col0; float s = 0.f;
#pragma unroll
                for (int bj = 0; bj < 2; ++bj)
#pragma unroll
                    for (int n = 0; n < 2; ++n) { const size_t c = off + bj * HALF + n * 16; const f32x4 o = *(const f32x4*)(x + c) + acc[ai][bj][m][n];
                        *(f32x4*)(x2 + c) = o; u32x2 w; w.x = cvt_pk_bf16(o[0], o[1]); w.y = cvt_pk_bf16(o[2], o[3]); *(u32x2*)(x2b + c) = w;
                        s += (o[0] * o[0] + o[1] * o[1]) + (o[2] * o[2] + o[3] * o[3]); }
                s += __shfl_xor(s, 16); s += __shfl_xor(s, 32);
                if (fq == 0) rowss[(size_t)row * 16 + u.pn * 4 + wc] = s;
                asm volatile("" ::: "memory"); }
    }
};
struct EpiPle {
    static constexpr bool PERM = false, AFTER_DRAIN = false, MIDK = false;
    float* xio; const bf16_t* pe; const float* rowss2; float* rowss3; int mid_t;
    __device__ __forceinline__ void mid(f32x4 (&)[2][2][4][2], const Unit&, int, int, int, int) const {}
    __device__ __forceinline__ void operator()(const f32x4 (&acc)[2][2][4][2], const Unit& u, int wr, int wc, int fr, int fq) const {
        const int col0 = u.pn * BM + wc * 32 + 4 * fq;
#pragma unroll
        for (int ai = 0; ai < 2; ++ai)
#pragma unroll
            for (int m = 0; m < 4; ++m) { const int row = u.pm * BM + ai * HALF + wr * 64 + m * 16 + fr; const size_t off = (size_t)row * 1024 + col0;
                const f32x4* rs = (const f32x4*)(rowss2 + (size_t)row * 16); const f32x4 q0 = rs[0], q1 = rs[1], q2 = rs[2], q3 = rs[3];
                const float ss = ((q0[0] + q0[1]) + (q0[2] + q0[3])) + ((q1[0] + q1[1]) + (q1[2] + q1[3])) + ((q2[0] + q2[1]) + (q2[2] + q2[3])) + ((q3[0] + q3[1]) + (q3[2] + q3[3]));
                const float rstd = __builtin_amdgcn_rsqf(ss * (1.f / 1024.f) + 1e-6f); float s = 0.f;
#pragma unroll
                for (int bj = 0; bj < 2; ++bj)
#pragma unroll
                    for (int n = 0; n < 2; ++n) { const size_t c = off + bj * HALF + n * 16; const f32x4 g = sigm4(acc[ai][bj][m][n] * rstd); const u32x2 pw = *(const u32x2*)(pe + c);
                        const f32x4 pv = (f32x4){bf_lo(pw.x), bf_hi(pw.x), bf_lo(pw.y), bf_hi(pw.y)}; const f32x4 o = *(const f32x4*)(xio + c) + g * pv;
                        *(f32x4*)(xio + c) = o; s += (o[0] * o[0] + o[1] * o[1]) + (o[2] * o[2] + o[3] * o[3]); }
                s += __shfl_xor(s, 16); s += __shfl_xor(s, 32);
                if (fq == 0) rowss3[(size_t)row * 16 + u.pn * 4 + wc] = s;
                asm volatile("" ::: "memory"); }
    }
};
struct PairOrder { StaticOrder S;
    __device__ __forceinline__ bool next(int i, Unit& u) const { Unit m; if (!S.next(i >> 1, m)) return false; u.pm = m.pm; u.pn = 28 + 2 * m.pn + (i & 1); return true; }
    __device__ __forceinline__ void a_ready(const Unit&) const {}
    __device__ __forceinline__ void done(const Unit&) const {}
};
struct GateOrder { int Gs, c;
    __device__ __forceinline__ bool next(int i, Unit& u) const { const int L = i * Gs + c; if (L >= 512) return false; u.pm = L >> 3; u.pn = 28 + (L & 7); return true; }
    __device__ __forceinline__ void a_ready(const Unit&) const {}
    __device__ __forceinline__ void done(const Unit&) const {}
};
struct ListOrder {
    int pm, pn0, cnt;
    __device__ __forceinline__ bool next(int i, Unit& u) const { if (i >= cnt) return false; u.pm = pm; u.pn = pn0 + i; return true; }
    __device__ __forceinline__ void a_ready(const Unit&) const {}
    __device__ __forceinline__ void done(const Unit&) const {}
};
template <class Epi, class Sched, bool ALIGN_EPI = false, bool SP2 = false>
__device__ __forceinline__ void gemm_phase(PG8_LAS unsigned char* lds, const Gemm g, const Sched& S, const Epi& E) {
    const int tid = threadIdx.x, wid = __builtin_amdgcn_readfirstlane(tid >> 6), lane = tid & 63, wr = wid >> 2, wc = wid & 3, fr = lane & 15, fq = lane >> 4;
    const int K = g.K, nt = K / BK;
    unsigned voffA[2], voffB[2];
#pragma unroll
    for (int i = 0; i < 2; ++i) { int R, C; stage_rc(tid * 16 + i * 8192, R, C); const int Rb = Epi::PERM ? ((R & ~31) + perm32(R & 31)) : R;
        voffA[i] = (unsigned)(R * K + C) * 2u; voffB[i] = (unsigned)(Rb * K + C) * 2u; }
    const size_t kstep = (size_t)(BK * 2);
    const size_t hstep = (size_t)HALF * K * 2;
    const size_t tstep = 2 * hstep;
    const unsigned ldsw = (unsigned)wid * 1024u;
    const int aoff = lds_byte(wr * 64 + fr, fq * 8), boff = lds_byte(wc * 32 + fr, fq * 8);
#define PG8_SA(b, h) (((b) * 2 + (h)) * HTB)
#define PG8_SB(b, h) ((4 + (b) * 2 + (h)) * HTB)
#define PG8_STAGE(bufoff, gbase, voff) do { _Pragma("unroll") for (int _i = 0; _i < 2; ++_i) \
        __builtin_amdgcn_global_load_lds((const unsigned*)((const char*)(gbase) + (voff)[_i]), (PG8_LAS unsigned*)(lds + (bufoff) + ldsw + _i * 8192), 16, 0, 0); } while (0)
#define PG8_LDA(dst, b, h) do { _Pragma("unroll") for (int m = 0; m < 4; ++m) _Pragma("unroll") for (int k = 0; k < 2; ++k) dst[m][k] = *(const PG8_LAS bf16x8*)(lds + PG8_SA(b, h) + aoff + m * 2048 + k * 1024); } while (0)
#define PG8_LDB(dst, b, h) do { _Pragma("unroll") for (int n = 0; n < 2; ++n) _Pragma("unroll") for (int k = 0; k < 2; ++k) dst[n][k] = *(const PG8_LAS bf16x8*)(lds + PG8_SB(b, h) + boff + n * 2048 + k * 1024); } while (0)
#define PG8_MMA(ai, bj, At, Bt) do { __builtin_amdgcn_s_setprio(1); _Pragma("unroll") for (int m = 0; m < 4; ++m) _Pragma("unroll") for (int n = 0; n < 2; ++n) _Pragma("unroll") for (int k = 0; k < 2; ++k) \
        acc[ai][bj][m][n] = __builtin_amdgcn_mfma_f32_16x16x32_bf16(Bt[n][k], At[m][k], acc[ai][bj][m][n], 0, 0, 0); __builtin_amdgcn_s_setprio(0); } while (0)
#define PG8_WAIT_V(n) asm volatile("s_waitcnt vmcnt(" #n ")" ::: "memory")
#define PG8_WAIT_L(n) asm volatile("s_waitcnt lgkmcnt(" #n ")" ::: "memory")
#define PG8_BAR __builtin_amdgcn_s_barrier()
#define PG8_SCHED __builtin_amdgcn_sched_barrier(0)
    Unit cur, nxt; int ui = 0;
    if (!S.next(0, cur)) return;
    f32x4 acc[2][2][4][2];
#pragma unroll
    for (int a = 0; a < 2; ++a)
#pragma unroll
        for (int b = 0; b < 2; ++b)
#pragma unroll
            for (int m = 0; m < 4; ++m)
#pragma unroll
                for (int n = 0; n < 2; ++n) acc[a][b][m][n] = (f32x4){0.f, 0.f, 0.f, 0.f};
    bf16x8 At[4][2], B0[2][2], B1[2][2];
    const char* cA = (const char*)g.A + (size_t)cur.pm * tstep; const char* cB = (const char*)g.Bt + (size_t)cur.pn * tstep;
    S.a_ready(cur);
    if constexpr (SP2) {
        PG8_STAGE(PG8_SB(0, 0), cB, voffB); PG8_STAGE(PG8_SB(0, 1), cB + hstep, voffB); PG8_STAGE(PG8_SA(0, 0), cA, voffA); PG8_STAGE(PG8_SA(0, 1), cA + hstep, voffA);
        if (wr == 1) PG8_BAR;
        PG8_WAIT_V(2); PG8_BAR;
        PG8_STAGE(PG8_SB(1, 0), cB + kstep, voffB); PG8_STAGE(PG8_SA(1, 0), cA + kstep, voffA); PG8_STAGE(PG8_SB(1, 1), cB + hstep + kstep, voffB);
        PG8_WAIT_V(6); PG8_BAR;
    } else {
        PG8_STAGE(PG8_SB(0, 0), cB, voffB); PG8_STAGE(PG8_SA(0, 0), cA, voffA); PG8_STAGE(PG8_SB(0, 1), cB + hstep, voffB); PG8_STAGE(PG8_SA(0, 1), cA + hstep, voffA);
        if (wr == 1) PG8_BAR;
        PG8_WAIT_V(4); PG8_BAR;
        PG8_STAGE(PG8_SB(1, 0), cB + kstep, voffB); PG8_STAGE(PG8_SA(1, 0), cA + kstep, voffA); PG8_STAGE(PG8_SB(1, 1), cB + hstep + kstep, voffB);
        PG8_WAIT_V(6); PG8_BAR;
    }
    for (;;) {
        const bool has_next = S.next(ui + 1, nxt);
        const char* nA = has_next ? (const char*)g.A + (size_t)nxt.pm * tstep : cA; const char* nB = has_next ? (const char*)g.Bt + (size_t)nxt.pn * tstep : cB;
        for (int t = 0; t < nt; t += 2) {
            if constexpr (Epi::MIDK) { if (t == E.mid_t) E.mid(acc, cur, wr, wc, fr, fq); }
            const bool last = (t == nt - 2);
            const char* a1 = cA + (size_t)(t + 1) * kstep;
            const char* a2 = last ? nA : cA + (size_t)(t + 2) * kstep; const char* b2 = last ? nB : cB + (size_t)(t + 2) * kstep;
            const char* a3 = a2 + kstep; const char* b3 = b2 + kstep;
            if (last && has_next) S.a_ready(nxt);
            if constexpr (SP2) {
            PG8_LDB(B0, 0, 0); PG8_LDB(B1, 0, 1); PG8_SCHED; PG8_LDA(At, 0, 0); PG8_STAGE(PG8_SA(1, 1), a1 + hstep, voffA);
            PG8_WAIT_V(8); PG8_WAIT_L(0); PG8_BAR; PG8_MMA(0, 0, At, B0); PG8_MMA(0, 1, At, B1); PG8_BAR; PG8_SCHED;
            PG8_LDA(At, 0, 1); PG8_STAGE(PG8_SB(0, 0), b2, voffB); PG8_STAGE(PG8_SB(0, 1), b2 + hstep, voffB); PG8_STAGE(PG8_SA(0, 0), a2, voffA);
            PG8_WAIT_V(8); PG8_WAIT_L(0); PG8_BAR; PG8_MMA(1, 0, At, B0); PG8_MMA(1, 1, At, B1); PG8_BAR; PG8_SCHED;
            PG8_LDB(B0, 1, 0); PG8_LDB(B1, 1, 1); PG8_SCHED; PG8_LDA(At, 1, 0); PG8_STAGE(PG8_SA(0, 1), a2 + hstep, voffA);
            PG8_WAIT_V(8); PG8_WAIT_L(0); PG8_BAR; PG8_MMA(0, 0, At, B0); PG8_MMA(0, 1, At, B1); PG8_BAR; PG8_SCHED;
            PG8_LDA(At, 1, 1); PG8_STAGE(PG8_SB(1, 0), b3, voffB); PG8_STAGE(PG8_SB(1, 1), b3 + hstep, voffB); PG8_STAGE(PG8_SA(1, 0), a3, voffA);
            PG8_WAIT_V(8); PG8_WAIT_L(0); PG8_BAR; PG8_MMA(1, 0, At, B0); PG8_MMA(1, 1, At, B1); PG8_BAR; PG8_SCHED;
            } else {
            PG8_LDB(B0, 0, 0); PG8_SCHED; PG8_LDA(At, 0, 0); PG8_STAGE(PG8_SA(1, 1), a1 + hstep, voffA);
            PG8_WAIT_L(8); PG8_BAR; PG8_WAIT_L(0); PG8_MMA(0, 0, At, B0); PG8_BAR; PG8_SCHED;
            PG8_LDB(B1, 0, 1); PG8_STAGE(PG8_SB(0, 0), b2, voffB);
            PG8_BAR; PG8_WAIT_L(0); PG8_MMA(0, 1, At, B1); PG8_BAR;
            PG8_LDA(At, 0, 1); PG8_STAGE(PG8_SA(0, 0), a2, voffA);
            PG8_BAR; PG8_WAIT_L(0); PG8_MMA(1, 0, At, B0); PG8_BAR; PG8_SCHED;
            PG8_STAGE(PG8_SB(0, 1), b2 + hstep, voffB);
            PG8_WAIT_V(6); PG8_BAR; PG8_MMA(1, 1, At, B1); PG8_BAR;
            PG8_LDB(B0, 1, 0); PG8_SCHED; PG8_LDA(At, 1, 0); PG8_STAGE(PG8_SA(0, 1), a2 + hstep, voffA);
            PG8_WAIT_L(8); PG8_BAR; PG8_WAIT_L(0); PG8_MMA(0, 0, At, B0); PG8_BAR; PG8_SCHED;
            PG8_LDB(B1, 1, 1); PG8_STAGE(PG8_SB(1, 0), b3, voffB);
            PG8_BAR; PG8_WAIT_L(0); PG8_MMA(0, 1, At, B1); PG8_BAR;
            PG8_LDA(At, 1, 1); PG8_STAGE(PG8_SA(1, 0), a3, voffA);
            PG8_BAR; PG8_WAIT_L(0); PG8_MMA(1, 0, At, B0); PG8_BAR; PG8_SCHED;
            PG8_STAGE(PG8_SB(1, 1), b3 + hstep, voffB);
            PG8_WAIT_V(6); PG8_BAR; PG8_MMA(1, 1, At, B1); PG8_BAR;
            }
        }
        if constexpr (ALIGN_EPI) { if (wr == 0) PG8_BAR; }
        if constexpr (!Epi::AFTER_DRAIN) { E(acc, cur, wr, wc, fr, fq); S.done(cur); }
        if (!has_next) break;
#pragma unroll
        for (int a = 0; a < 2; ++a)
#pragma unroll
            for (int b = 0; b < 2; ++b)
#pragma unroll
                for (int m = 0; m < 4; ++m)
#pragma unroll
                    for (int n = 0; n < 2; ++n) acc[a][b][m][n] = (f32x4){0.f, 0.f, 0.f, 0.f};
        cur = nxt; cA = nA; cB = nB; ++ui;
        if constexpr (ALIGN_EPI) { if (wr == 1) PG8_BAR; }
    }
    PG8_WAIT_V(0);
    if constexpr (!ALIGN_EPI) { if (wr == 0) PG8_BAR; }
    PG8_BAR;
    if constexpr (Epi::AFTER_DRAIN) { E.fused(acc, cur, wr, wc, fr, fq, lds, wid, lane); S.done(cur); }
#undef PG8_SA
#undef PG8_SB
#undef PG8_STAGE
#undef PG8_LDA
#undef PG8_LDB
#undef PG8_MMA
#undef PG8_WAIT_V
#undef PG8_WAIT_L
#undef PG8_BAR
#undef PG8_SCHED
}
}

constexpr int T_TOK = 16384, SEQ = 8192, DM = 1024, IN_COLS = 9232, NCHUNK = SEQ / 64;
constexpr float EPS = 1e-6f;
constexpr int NWAVES = 8, NTHREADS = 512;
constexpr size_t MiB = 1u << 20;
constexpr size_t WS_CTL = 0, CTL_ZERO_BYTES = 1 * MiB;
constexpr size_t WS_WIN = 1 * MiB;
constexpr size_t WS_GKLOW = 19 * MiB;
constexpr size_t WS_DECAY = 20 * MiB;
constexpr size_t WS_ROWSS2 = 21 * MiB;
constexpr size_t WS_QK = 22 * MiB;
constexpr size_t WS_ACAT = 54 * MiB;
constexpr size_t WS_SZA = 118 * MiB;
constexpr size_t WS_WCX = 150 * MiB;
constexpr size_t WS_US = 182 * MiB;
constexpr size_t WS_WCAT = 246 * MiB;
constexpr size_t WS_WOUT = 250 * MiB;
constexpr size_t WS_WPG = 252 * MiB;
constexpr size_t WS_WPE = 254 * MiB;
constexpr size_t WS_END = 256 * MiB;
constexpr size_t OUT_H = 0, OUT_PB = 32 * MiB, OUT_AMAT = 40 * MiB;
constexpr int RING_BYTES = 131072, LDS_BYTES = 163840, MISC_OFF = LDS_BYTES - 256;

#define LAS __attribute__((address_space(3)))
typedef unsigned short bf16_t;
typedef float f32x4 __attribute__((ext_vector_type(4)));
typedef unsigned u32x4 __attribute__((ext_vector_type(4)));
typedef unsigned u32x2 __attribute__((ext_vector_type(2)));
using pg8::cvt_pk_bf16; using pg8::bf_lo; using pg8::bf_hi;
#define LDS_WAIT() asm volatile("s_waitcnt lgkmcnt(0)" ::: "memory")
__device__ __forceinline__ float bf2f(bf16_t v) { return __uint_as_float((unsigned)v << 16); }
__device__ __forceinline__ float wave_sum(float v) {
#pragma unroll
    for (int o = 1; o < 64; o <<= 1) v += __shfl_xor(v, o);
    return v;
}

struct Params {
    const float *x, *p, *norm_mix_g, *w_in, *b_merge, *w_gk2, *b_gk, *gla_norm_g, *conv_w, *w_a, *w_c, *w_out, *norm_ple_g, *w_pg, *w_pe, *norm_final_g;
    float* out; unsigned char* ws; int ph_lo, ph_hi;
};

__device__ __forceinline__ void transpose_item(const float* src, int srcN, int col0, int k0, bf16_t* dst, int dstK, int drow0, int dk0, const float* kscale, LAS float* scr, int lane) {
#pragma unroll 8
    for (int i = 0; i < 32; ++i) { const int kk = 2 * i + (lane >> 5); float v = src[(size_t)(k0 + kk) * srcN + col0 + (lane & 31)]; if (kscale) v *= kscale[k0 + kk]; scr[kk * 33 + (lane & 31)] = v; }
    LDS_WAIT(); asm volatile("" ::: "memory");
    const int c = lane & 7;
#pragma unroll
    for (int j = 0; j < 4; ++j) { const int n = (lane >> 3) + 8 * j; const LAS float* s = scr + (8 * c) * 33 + n;
        u32x4 o; o.x = cvt_pk_bf16(s[0 * 33], s[1 * 33]); o.y = cvt_pk_bf16(s[2 * 33], s[3 * 33]); o.z = cvt_pk_bf16(s[4 * 33], s[5 * 33]); o.w = cvt_pk_bf16(s[6 * 33], s[7 * 33]);
        *(u32x4*)(dst + (size_t)(drow0 + n) * dstK + dk0 + k0 + 8 * c) = o; }
    LDS_WAIT(); asm volatile("" ::: "memory");
}
__device__ __forceinline__ int win_colmap(int np) {
    const int tile = np >> 8, r = np & 255;
    if (tile < 12) return np;
    if (tile < 20) { const int j = tile - 12; return r < 128 ? 4112 + 128 * j + r : 5136 + 128 * j + (r - 128); }
    if (tile < 28) { const int j = tile - 20; return r < 128 ? 3088 + 128 * j + r : 6160 + 128 * j + (r - 128); }
    const int j = tile - 28; return r < 128 ? 7184 + 128 * j + r : 8208 + 128 * j + (r - 128);
}
__device__ __forceinline__ void p0_prologue(const Params& P, LAS unsigned char* lds, int tid, int lane, int wave, int vcu, int G) {
    bf16_t* WIN_T = (bf16_t*)(P.ws + WS_WIN); bf16_t* WCAT_T = (bf16_t*)(P.ws + WS_WCAT); bf16_t* WOUT_T = (bf16_t*)(P.ws + WS_WOUT); bf16_t* WPG_T = (bf16_t*)(P.ws + WS_WPG); bf16_t* WPE_T = (bf16_t*)(P.ws + WS_WPE);
    bf16_t* H = (bf16_t*)((unsigned char*)P.out + OUT_H); bf16_t* PB = (bf16_t*)((unsigned char*)P.out + OUT_PB); float* GKLOW = (float*)(P.ws + WS_GKLOW);
    LAS float* scr = (LAS float*)(lds + wave * 16384);
    const int gw = vcu * NWAVES + wave, NGW = G * NWAVES;
    constexpr int I_IN = 16 * 288, I_SQ = 16 * 32, I_PE = 4 * 32, NITEMS = I_IN + 4 * I_SQ + I_PE;
    for (int it = gw; it < (NITEMS << PROBE_REP_P0); it += NGW) {
        int r = it >= NITEMS ? it - NITEMS : it;
        if (r < I_IN) { const int kb = r / 288, nb = r % 288; transpose_item(P.w_in, IN_COLS, win_colmap(32 * nb), 64 * kb, WIN_T, 1024, 32 * nb, 0, nullptr, scr, lane); continue; } r -= I_IN;
        const int kb = r / 32 % 16, nb = r % 32, which = r / I_SQ;
        if (which == 0) transpose_item(P.w_a, 1024, 32 * nb, 64 * kb, WCAT_T, 2048, 32 * nb, 0, nullptr, scr, lane);
        else if (which == 1) transpose_item(P.w_c, 1024, 32 * nb, 64 * kb, WCAT_T, 2048, 32 * nb, 1024, nullptr, scr, lane);
        else if (which == 2) transpose_item(P.w_out, 1024, 32 * nb, 64 * kb, WOUT_T, 1024, 32 * nb, 0, nullptr, scr, lane);
        else if (which == 3) transpose_item(P.w_pg, 1024, 32 * nb, 64 * kb, WPG_T, 1024, 32 * nb, 0, P.norm_ple_g, scr, lane);
        else { const int r2 = r - 4 * I_SQ; transpose_item(P.w_pe, 1024, 32 * (r2 % 32), 64 * (r2 / 32), WPE_T, 256, 32 * (r2 % 32), 0, nullptr, scr, lane); }
    }
    for (int ee = vcu * NTHREADS + tid; ee < ((T_TOK * 256 / 8) << PROBE_REP_P0); ee += G * NTHREADS) { const int e = ee & (T_TOK * 256 / 8 - 1); const f32x4 a = *(const f32x4*)(P.p + (size_t)e * 8), b = *(const f32x4*)(P.p + (size_t)e * 8 + 4);
        *(u32x4*)(PB + (size_t)e * 8) = pg8::pack8(a, b); }
    __syncthreads();
    LAS float* WgT = (LAS float*)lds;
    for (int e = tid; e < 16 * 1024; e += NTHREADS) { const int k = e >> 4, c = e & 15; WgT[c * 1024 + k] = P.w_in[(size_t)k * IN_COLS + 3072 + c]; }
    __syncthreads();
    f32x4 gv[4];
#pragma unroll
    for (int j = 0; j < 4; ++j) gv[j] = *(const f32x4*)(P.norm_mix_g + 4 * lane + 256 * j);
    for (int prr = gw; prr < ((T_TOK / 2) << PROBE_REP_P0); prr += NGW) { const int pr = prr & (T_TOK / 2 - 1);
        f32x4 hv[2][4];
#pragma unroll
        for (int r = 0; r < 2; ++r) { const float* xr = P.x + (size_t)(2 * pr + r) * DM; float ss = 0.f;
#pragma unroll
            for (int j = 0; j < 4; ++j) { hv[r][j] = *(const f32x4*)(xr + 4 * lane + 256 * j); ss += (hv[r][j][0] * hv[r][j][0] + hv[r][j][1] * hv[r][j][1]) + (hv[r][j][2] * hv[r][j][2] + hv[r][j][3] * hv[r][j][3]); }
            const float rstd = 1.0f / sqrtf(wave_sum(ss) * (1.f / DM) + EPS);
            bf16_t* hr = H + (size_t)(2 * pr + r) * DM;
#pragma unroll
            for (int j = 0; j < 4; ++j) { hv[r][j] = hv[r][j] * rstd * gv[j]; u32x2 w; w.x = cvt_pk_bf16(hv[r][j][0], hv[r][j][1]); w.y = cvt_pk_bf16(hv[r][j][2], hv[r][j][3]); *(u32x2*)(hr + 4 * lane + 256 * j) = w; } }
        float a[32];
#pragma unroll
        for (int c = 0; c < 16; ++c) { float s0 = 0.f, s1 = 0.f;
#pragma unroll
            for (int j = 0; j < 4; ++j) { const f32x4 w = *(const LAS f32x4*)(WgT + c * 1024 + 4 * lane + 256 * j);
                s0 += (hv[0][j][0] * w[0] + hv[0][j][1] * w[1]) + (hv[0][j][2] * w[2] + hv[0][j][3] * w[3]); s1 += (hv[1][j][0] * w[0] + hv[1][j][1] * w[1]) + (hv[1][j][2] * w[2] + hv[1][j][3] * w[3]); }
            a[c] = s0; a[16 + c] = s1; }
#pragma unroll
        for (int o = 32, n = 16; n >= 1; o >>= 1, n >>= 1) { const bool up = (lane & o) != 0;
#pragma unroll
            for (int i = 0; i < n; ++i) { const float send = up ? a[i] : a[i + n], keep = up ? a[i + n] : a[i]; a[i] = keep + __shfl_xor(send, o); } }
        a[0] += __shfl_xor(a[0], 1);
        if ((lane & 1) == 0) { const int idx = lane >> 1; GKLOW[(size_t)(2 * pr + (idx >> 4)) * 16 + (idx & 15)] = a[0]; }
    }
}

typedef short bf16x8 __attribute__((ext_vector_type(8)));
typedef float f32x16 __attribute__((ext_vector_type(16)));
constexpr int REC_BYTES = 43008, REC_QI = 0, REC_KDT = 16384, REC_AM = 32768, REC_DEC = 40960;
__device__ __forceinline__ int img256(int row, int col) { return row * 256 + ((((col >> 3) ^ (row & 15))) << 4) + (col & 7) * 2; }
__device__ __forceinline__ int img128(int row, int col) { return row * 128 + ((((col >> 3) ^ ((row >> 1) & 7))) << 4) + (col & 7) * 2; }
typedef float f32x2c __attribute__((ext_vector_type(2))); typedef __bf16 bf16x2c __attribute__((ext_vector_type(2)));
__device__ __forceinline__ unsigned cvt_pk_c(float lo, float hi) { const f32x2c v = {lo, hi}; const bf16x2c b = __builtin_convertvector(v, bf16x2c); return __builtin_bit_cast(unsigned, b); }
__device__ __forceinline__ bf16_t f2bf(float v) { return (bf16_t)(cvt_pk_c(v, 0.f) & 0xffffu); }
__device__ __forceinline__ bf16x8 lds_frag(LAS unsigned char* p) { return *(LAS bf16x8*)p; }

__device__ __forceinline__ void gla_prep(const Params& P, LAS unsigned char* lds, int tid, int lane, int wave, int vcu, int G) {
    const bf16_t* QK = (const bf16_t*)(P.ws + WS_QK); const float* GKLOW = (const float*)(P.ws + WS_GKLOW); unsigned char* REC = P.ws + WS_US;
    LAS float* gl = (LAS float*)lds; LAS float* tot = (LAS float*)(lds + 4096); LAS unsigned char* Qi = lds + 8192; LAS unsigned char* Ki = lds + 24576; LAS unsigned char* Am = lds + 40960;
    const int d = tid & 127, tg = tid >> 7, r32 = lane & 31, hh = lane >> 5;
    for (int uu = vcu; uu < (1024 << PROBE_REP_PREP); uu += G) { const int u = uu & 1023;
        const int h = u & 3, n = (u >> 2) & 127, b = u >> 9, t0 = b * SEQ + n * 64;
        unsigned char* rec = REC + (size_t)u * REC_BYTES;
        for (int e = tid; e < 1024; e += NTHREADS) gl[e] = GKLOW[(size_t)t0 * 16 + e];
        float qv[16], kv[16], w2[16];
#pragma unroll
        for (int i = 0; i < 16; ++i) { const size_t t = (size_t)(t0 + 16 * tg + i); qv[i] = bf2f(QK[t * 1024 + h * 128 + d]); kv[i] = bf2f(QK[t * 1024 + 512 + h * 128 + d]); }
#pragma unroll
        for (int r = 0; r < 16; ++r) w2[r] = P.w_gk2[r * 512 + h * 128 + d];
        const float bias = P.b_gk[h * 128 + d];
        __syncthreads();
        float c[16]; float run = 0.f;
#pragma unroll
        for (int i = 0; i < 16; ++i) { float z = bias;
#pragma unroll
            for (int r4 = 0; r4 < 4; ++r4) { const f32x4 g4 = *(const LAS f32x4*)(gl + (16 * tg + i) * 16 + 4 * r4); z += (g4[0] * w2[4 * r4] + g4[1] * w2[4 * r4 + 1]) + (g4[2] * w2[4 * r4 + 2] + g4[3] * w2[4 * r4 + 3]); }
            const float gk = (fminf(z, 0.f) - __logf(1.f + __expf(-fabsf(z)))) * (1.f / 16.f); run += gk; c[i] = run; }
        tot[tg * 128 + d] = run;
        __syncthreads();
        float off = 0.f, total = 0.f;
#pragma unroll
        for (int g = 0; g < 4; ++g) { const float v = tot[g * 128 + d]; total += v; if (g < tg) off += v; }
        float kd[16];
#pragma unroll
        for (int i = 0; i < 16; ++i) { const float bb = off + c[i]; const int t = 16 * tg + i;
            *(LAS bf16_t*)(Qi + img256(t, d)) = f2bf(qv[i] * 0.08838834764831845f * __expf(bb));
            *(LAS bf16_t*)(Ki + img256(t, d)) = f2bf(kv[i] * __expf(-bb));
            kd[i] = kv[i] * __expf(total - bb); }
        {
            u32x4 w0, w1; w0.x = cvt_pk_bf16(kd[0], kd[1]); w0.y = cvt_pk_bf16(kd[2], kd[3]); w0.z = cvt_pk_bf16(kd[4], kd[5]); w0.w = cvt_pk_bf16(kd[6], kd[7]);
            w1.x = cvt_pk_bf16(kd[8], kd[9]); w1.y = cvt_pk_bf16(kd[10], kd[11]); w1.z = cvt_pk_bf16(kd[12], kd[13]); w1.w = cvt_pk_bf16(kd[14], kd[15]);
            *(u32x4*)(rec + REC_KDT + img128(d, 16 * tg)) = w0; *(u32x4*)(rec + REC_KDT + img128(d, 16 * tg + 8)) = w1; }
        if (tg == 0) ((float*)(rec + REC_DEC))[d] = __expf(total);
        __syncthreads();
        if (wave < 4) {
            const int mi = wave >> 1, nj = wave & 1, ra = 32 * mi + r32, rb = 32 * nj + r32;
            f32x16 acc;
#pragma unroll
            for (int e = 0; e < 16; ++e) acc[e] = 0.f;
#pragma unroll
            for (int s = 0; s < 8; ++s) { const bf16x8 a = lds_frag(Qi + ra * 256 + ((((2 * s + hh) ^ (ra & 15))) << 4)), bq = lds_frag(Ki + rb * 256 + ((((2 * s + hh) ^ (rb & 15))) << 4));
                acc = __builtin_amdgcn_mfma_f32_32x32x16_bf16(a, bq, acc, 0, 0, 0); }
            const int j = 32 * nj + r32;
#pragma unroll
            for (int e = 0; e < 16; ++e) { const int i = 32 * mi + (e & 3) + 8 * (e >> 2) + 4 * hh; *(LAS bf16_t*)(Am + img128(i, j)) = f2bf(j <= i ? acc[e] : 0.f); }
        }
#pragma unroll
        for (int k = 0; k < 2; ++k) { const int ch = tid + NTHREADS * k; *(u32x4*)(rec + REC_QI + ch * 16) = *(LAS u32x4*)(Qi + ch * 16); }
        __syncthreads();
        *(u32x4*)(rec + REC_AM + tid * 16) = *(LAS u32x4*)(Am + tid * 16);
        __syncthreads();
    }
}

typedef short s16x4 __attribute__((ext_vector_type(4)));
__device__ __forceinline__ s16x4 lds_tr(LAS unsigned char* p) { return __builtin_bit_cast(s16x4, __builtin_amdgcn_ds_read_tr16_b64_v4i16((LAS s16x4*)p)); }
__device__ __forceinline__ void gla_scan(const Params& P, LAS unsigned char* lds, int tid, int lane, int wave, int bh, int dvs) {
    const unsigned char* REC = P.ws + WS_US; bf16_t* ACAT = (bf16_t*)(P.ws + WS_ACAT); bf16_t* O = ACAT;
    constexpr int BUF = 47104, B_QI = 0, B_KDT = 16384, B_AM = 32768, B_DEC = 40960, B_VT = 43008, ST0 = 3 * BUF, ST_BYTES = 8192;
    static_assert(ST0 + 2 * ST_BYTES <= MISC_OFF && REC_BYTES == 7 * 384 * 16 && B_VT == REC_BYTES, "scan LDS map");
    const int b = bh >> 2, h = bh & 3, r32 = lane & 31, hh = lane >> 5;
    const size_t ubase = ((size_t)b * 128) * 4 + h;
    const int vtid = tid - 384;
    const unsigned char* vsrc = (const unsigned char*)(ACAT + (size_t)(b * SEQ + (vtid >> 2)) * 2048 + h * 256 + dvs * 32 + (vtid & 3) * 8);
    const int vrd = B_VT + (8 * hh + ((lane & 15) >> 2)) * 64 + (16 * ((lane >> 4) & 1) + 4 * (lane & 3)) * 2;
#define SCAN_STAGE(nn, bufi) do { const unsigned char* src_ = REC + (ubase + 4 * (size_t)(nn)) * REC_BYTES; \
        _Pragma("unroll") for (int k_ = 0; k_ < 7; ++k_) __builtin_amdgcn_global_load_lds((const unsigned*)(src_ + (size_t)(k_ * 384 + tid) * 16), (LAS unsigned*)(lds + (bufi) * BUF + (k_ * 384 + wave * 64) * 16), 16, 0, 0); } while (0)
#define SCAN_VSTAGE(nn, bufi) do { const unsigned char* src_ = vsrc + (size_t)(nn) * 64 * 4096; \
        _Pragma("unroll") for (int k_ = 0; k_ < 2; ++k_) __builtin_amdgcn_global_load_lds((const unsigned*)(src_ + (size_t)k_ * 32 * 4096), (LAS unsigned*)(lds + (bufi) * BUF + B_VT + (k_ * 128 + (wave - 6) * 64) * 16), 16, 0, 0); } while (0)
#define SCAN_VFRAG(s_) __builtin_shufflevector(lds_tr(bufc + vrd + (16 * (s_)) * 64), lds_tr(bufc + vrd + (16 * (s_) + 4) * 64), 0, 1, 2, 3, 4, 5, 6, 7)
    f32x16 accS;
#pragma unroll
    for (int e = 0; e < 16; ++e) accS[e] = 0.f;
    const int kq = wave - 2;
    if (wave < 6) { SCAN_STAGE(0, 0); SCAN_STAGE(1, 1); } else { SCAN_VSTAGE(0, 0); SCAN_VSTAGE(1, 1); }
    for (int e = tid; e < ST_BYTES / 16; e += NTHREADS) *(LAS u32x4*)(lds + ST0 + e * 16) = (u32x4){0u, 0u, 0u, 0u};
    if (wave < 6) asm volatile("s_waitcnt vmcnt(7) lgkmcnt(0)" ::: "memory"); else asm volatile("s_waitcnt vmcnt(2) lgkmcnt(0)" ::: "memory");
    __builtin_amdgcn_s_barrier(); asm volatile("" ::: "memory");
    int slot = 0;
    for (int n = 0; n < 128; ++n) {
        const int cur = n & 1, s1 = (slot == 2) ? 0 : slot + 1, s2 = (s1 == 2) ? 0 : s1 + 1;
        LAS unsigned char* bufc = lds + slot * BUF; LAS unsigned char* stc = lds + ST0 + cur * ST_BYTES; LAS unsigned char* stn = lds + ST0 + (cur ^ 1) * ST_BYTES;
        if (n + 2 < 128) { if (wave < 6) SCAN_STAGE(n + 2, s2); else SCAN_VSTAGE(n + 2, s2); }
        if (wave < 2) {
            const int ra = 32 * wave + r32;
            f32x16 acc;
#pragma unroll
            for (int e = 0; e < 16; ++e) acc[e] = 0.f;
#pragma unroll
            for (int s = 0; s < 4; ++s) { const bf16x8 a = lds_frag(bufc + B_AM + ra * 128 + ((((2 * s + hh) ^ ((ra >> 1) & 7))) << 4)); const bf16x8 bv = SCAN_VFRAG(s);
                acc = __builtin_amdgcn_mfma_f32_32x32x16_bf16(a, bv, acc, 0, 0, 0); }
#pragma unroll
            for (int s = 0; s < 8; ++s) { const bf16x8 a = lds_frag(bufc + B_QI + ra * 256 + ((((2 * s + hh) ^ (ra & 15))) << 4)), bs = lds_frag(stc + r32 * 256 + ((((2 * s + hh) ^ (r32 & 15))) << 4));
                acc = __builtin_amdgcn_mfma_f32_32x32x16_bf16(a, bs, acc, 0, 0, 0); }
            bf16_t* orow = O + (size_t)(b * SEQ + n * 64 + 32 * wave + 4 * hh) * 2048 + h * 256 + dvs * 32 + r32;
#pragma unroll
            for (int e = 0; e < 16; ++e) orow[(size_t)((e & 3) + 8 * (e >> 2)) * 2048] = f2bf(acc[e]);
        } else if (wave < 6) {
            const int ra = 32 * kq + r32;
#pragma unroll
            for (int g = 0; g < 4; ++g) { const f32x4 dc = *(const LAS f32x4*)(bufc + B_DEC + (32 * kq + 8 * g + 4 * hh) * 4);
#pragma unroll
                for (int e = 0; e < 4; ++e) accS[4 * g + e] *= dc[e]; }
#pragma unroll
            for (int s = 0; s < 4; ++s) { const bf16x8 a = lds_frag(bufc + B_KDT + ra * 128 + ((((2 * s + hh) ^ ((ra >> 1) & 7))) << 4)); const bf16x8 bv = SCAN_VFRAG(s);
                accS = __builtin_amdgcn_mfma_f32_32x32x16_bf16(a, bv, accS, 0, 0, 0); }
#pragma unroll
            for (int g = 0; g < 4; ++g) { u32x2 w; w.x = cvt_pk_c(accS[4 * g], accS[4 * g + 1]); w.y = cvt_pk_c(accS[4 * g + 2], accS[4 * g + 3]);
                *(LAS u32x2*)(stn + r32 * 256 + ((((4 * kq + g) ^ (r32 & 15))) << 4) + 8 * hh) = w; }
        }
        if (n + 2 < 128) { if (wave < 2) asm volatile("s_waitcnt vmcnt(23) lgkmcnt(0)" ::: "memory"); else if (wave < 6) asm volatile("s_waitcnt vmcnt(7) lgkmcnt(0)" ::: "memory"); else asm volatile("s_waitcnt vmcnt(2) lgkmcnt(0)" ::: "memory"); }
        else asm volatile("s_waitcnt vmcnt(0) lgkmcnt(0)" ::: "memory");
        __builtin_amdgcn_s_barrier(); asm volatile("" ::: "memory");
        slot = s1;
    }
    asm volatile("s_waitcnt vmcnt(0) lgkmcnt(0)" ::: "memory"); __syncthreads();
#undef SCAN_STAGE
#undef SCAN_VSTAGE
#undef SCAN_VFRAG
}

__device__ __forceinline__ void gla_fin(const Params& P, int lane, int gw, int NGW) {
    const bf16_t* SZA = (const bf16_t*)(P.ws + WS_SZA); bf16_t* ACAT = (bf16_t*)(P.ws + WS_ACAT);
    f32x4 gn[2]; gn[0] = *(const f32x4*)(P.gla_norm_g + ((8 * lane) & 255)); gn[1] = *(const f32x4*)(P.gla_norm_g + ((8 * lane) & 255) + 4);
    for (int t = gw; t < T_TOK; t += NGW) {
        f32x4 o0[2], o1[2], z0[2], z1[2];
#pragma unroll
        for (int j = 0; j < 2; ++j) { const size_t c0 = (size_t)512 * j + 8 * lane; pg8::unpack8(*(const u32x4*)(ACAT + (size_t)t * 2048 + c0), o0[j], o1[j]); pg8::unpack8(*(const u32x4*)(SZA + (size_t)t * 1024 + c0), z0[j], z1[j]); }
#pragma unroll
        for (int j = 0; j < 2; ++j) { const size_t c0 = (size_t)512 * j + 8 * lane;
            float ss = ((o0[j][0] * o0[j][0] + o0[j][1] * o0[j][1]) + (o0[j][2] * o0[j][2] + o0[j][3] * o0[j][3])) + ((o1[j][0] * o1[j][0] + o1[j][1] * o1[j][1]) + (o1[j][2] * o1[j][2] + o1[j][3] * o1[j][3]));
#pragma unroll
            for (int m = 1; m < 32; m <<= 1) ss += __shfl_xor(ss, m);
            const float rstd = 1.0f / sqrtf(ss * (1.f / 256.f) + EPS);
            *(u32x4*)(ACAT + (size_t)t * 2048 + c0) = pg8::pack8(o0[j] * rstd * gn[0] * z0[j], o1[j] * rstd * gn[1] * z1[j]); }
    }
}
__device__ __forceinline__ void conv_rows(const Params& P, int lane, int gw, int NGW) {
    const bf16_t* WCX = (const bf16_t*)(P.ws + WS_WCX); bf16_t* ACAT = (bf16_t*)(P.ws + WS_ACAT);
    f32x4 cw[2][3][2];
#pragma unroll
    for (int j = 0; j < 2; ++j)
#pragma unroll
        for (int k = 0; k < 3; ++k) { cw[j][k][0] = *(const f32x4*)(P.conv_w + k * 1024 + 512 * j + 8 * lane); cw[j][k][1] = *(const f32x4*)(P.conv_w + k * 1024 + 512 * j + 8 * lane + 4); }
    for (int t = gw; t < T_TOK; t += NGW) {
        const int tl = t & (SEQ - 1);
        u32x4 wg[2], wc[2], wb[2], wa[2];
#pragma unroll
        for (int j = 0; j < 2; ++j) { const size_t c0 = (size_t)512 * j + 8 * lane;
            wg[j] = *(const u32x4*)(ACAT + (size_t)t * 2048 + 1024 + c0); wc[j] = *(const u32x4*)(WCX + (size_t)t * 1024 + c0);
            wb[j] = (tl >= 1) ? *(const u32x4*)(WCX + (size_t)(t - 1) * 1024 + c0) : (u32x4){0u, 0u, 0u, 0u}; wa[j] = (tl >= 2) ? *(const u32x4*)(WCX + (size_t)(t - 2) * 1024 + c0) : (u32x4){0u, 0u, 0u, 0u}; }
#pragma unroll
        for (int j = 0; j < 2; ++j) { const size_t c0 = (size_t)512 * j + 8 * lane;
            f32x4 g0, g1, a0, a1, b0, b1, c0v, c1v; pg8::unpack8(wg[j], g0, g1); pg8::unpack8(wc[j], c0v, c1v); pg8::unpack8(wb[j], b0, b1); pg8::unpack8(wa[j], a0, a1);
            const f32x4 u0 = cw[j][0][0] * a0 + cw[j][1][0] * b0 + cw[j][2][0] * c0v, u1 = cw[j][0][1] * a1 + cw[j][1][1] * b1 + cw[j][2][1] * c1v;
            *(u32x4*)(ACAT + (size_t)t * 2048 + 1024 + c0) = pg8::pack8(g0 * u0, g1 * u1); }
    }
}

__device__ __forceinline__ void final_norm(const Params& P, int lane, int gw, int NGW) {
    const float* RS3 = (const float*)(P.ws + WS_GKLOW);
    f32x4 gv[4];
#pragma unroll
    for (int j = 0; j < 4; ++j) gv[j] = *(const f32x4*)(P.norm_final_g + 4 * lane + 256 * j);
    for (int row = gw; row < T_TOK; row += NGW) {
        const f32x4* rs = (const f32x4*)(RS3 + (size_t)row * 16); const f32x4 q0 = rs[0], q1 = rs[1], q2 = rs[2], q3 = rs[3];
        const float ss = ((q0[0] + q0[1]) + (q0[2] + q0[3])) + ((q1[0] + q1[1]) + (q1[2] + q1[3])) + ((q2[0] + q2[1]) + (q2[2] + q2[3])) + ((q3[0] + q3[1]) + (q3[2] + q3[3]));
        const float rstd = 1.0f / sqrtf(ss * (1.f / DM) + EPS);
        float* o = P.out + (size_t)row * DM;
#pragma unroll
        for (int j = 0; j < 4; ++j) { const f32x4 v = *(const f32x4*)(o + 4 * lane + 256 * j); *(f32x4*)(o + 4 * lane + 256 * j) = v * rstd * gv[j]; }
    }
}

#define RLX_AGENT __ATOMIC_RELAXED, __HIP_MEMORY_SCOPE_AGENT
#define XB_TMO      128
#define XB_XCNT(j)  (256  + 64 * (j))
#define XB_XSUB(j)  (1280 + 64 * (j))
#define XB_XGEN(j)  (2304 + 64 * (j))
#define XB_TOP      3328
#define XB_TOPGEN   3392
#define XCD_BAR_WORDS 3456
#define XB_SPIN_CAP (1u << 18)

__device__ __forceinline__ unsigned xb_ld(unsigned* p)              { return __hip_atomic_load(p, __ATOMIC_RELAXED, __HIP_MEMORY_SCOPE_AGENT); }
__device__ __forceinline__ unsigned xb_add(unsigned* p, unsigned v) { return __hip_atomic_fetch_add(p, v, __ATOMIC_RELAXED, __HIP_MEMORY_SCOPE_AGENT); }
__device__ __forceinline__ unsigned xb_xcc_id() { return (unsigned)__builtin_amdgcn_s_getreg((3 << 11) | 20) & 0xFu; }
#define XB_SPIN(cond, bar) do { unsigned _sp = 0; while (cond) { __builtin_amdgcn_s_sleep(1); \
    if ((++_sp & 255u) == 0u) { if (xb_ld(&(bar)[XB_TMO])) break; if (_sp > XB_SPIN_CAP) { atomicAdd(&(bar)[XB_TMO], 1u); break; } } } } while (0)

struct XcdBarrier {
    unsigned* bar; unsigned x;
    volatile LAS unsigned* st;
};

__device__ __forceinline__ XcdBarrier xcd_barrier_post(unsigned* bar, volatile LAS unsigned* st) {
    XcdBarrier b; b.bar = bar; b.x = xb_xcc_id(); b.st = st;
    if (threadIdx.x == 0) (void)xb_add(&bar[XB_XCNT(b.x)], 1u);
    return b;
}
__device__ __forceinline__ void xcd_barrier_complete(unsigned* bar, unsigned x, unsigned& nloc, unsigned& nx) {
    const unsigned G = gridDim.x * gridDim.y * gridDim.z;
    unsigned sum, cnt, mine, sp = 0u;
    for (;;) {
        sum = 0u; cnt = 0u; mine = 0u;
#pragma unroll
        for (unsigned j = 0; j < 16; ++j) { const unsigned c = xb_ld(&bar[XB_XCNT(j)]); sum += c; cnt += (c > 0u) ? 1u : 0u; mine = (j == x) ? c : mine; }
        if (sum == G) break;
        __builtin_amdgcn_s_sleep(1);
        if ((++sp & 255u) == 0u) { if (xb_ld(&bar[XB_TMO])) break; if (sp > XB_SPIN_CAP) { atomicAdd(&bar[XB_TMO], 1u); break; } }
    }
    nloc = mine > 0u ? mine : 1u; nx = cnt > 0u ? cnt : 1u;
}

__device__ __forceinline__ void xcd_barrier(const XcdBarrier& b) {
    asm volatile("s_waitcnt vmcnt(0)" ::: "memory");
    __syncthreads();
    if (threadIdx.x == 0) {
        unsigned* bar = b.bar;
        __builtin_amdgcn_s_waitcnt(0);
        unsigned nloc = b.st[0], nx = b.st[1];
        if (nloc == 0u) { xcd_barrier_complete(bar, b.x, nloc, nx); b.st[0] = nloc; b.st[1] = nx; }
        const unsigned old = xb_add(&bar[XB_XSUB(b.x)], 1u);
        const unsigned gen = old / nloc;
        if (old + 1u == (gen + 1u) * nloc) {
            __builtin_amdgcn_fence(__ATOMIC_RELEASE, "agent");
            asm volatile("s_waitcnt vmcnt(0)" ::: "memory");
            const unsigned og = xb_add(&bar[XB_TOP], 1u);
            const unsigned tg = og / nx;
            if (og + 1u == (tg + 1u) * nx) xb_add(&bar[XB_TOPGEN], 1u);
            else XB_SPIN(xb_ld(&bar[XB_TOPGEN]) == tg, bar);
            __builtin_amdgcn_fence(__ATOMIC_ACQUIRE, "agent");
            xb_add(&bar[XB_XGEN(b.x)], 1u);
            asm volatile("s_waitcnt vmcnt(0)" ::: "memory");
        } else {
            XB_SPIN(xb_ld(&bar[XB_XGEN(b.x)]) == gen, bar);
            __builtin_amdgcn_fence(__ATOMIC_ACQUIRE, "agent");
            asm volatile("s_waitcnt vmcnt(0)" ::: "memory");
        }
    }
    __syncthreads();
}


constexpr int N_PHASES = 9;
#ifndef SKIPMASK
#define SKIPMASK 0
#endif

#ifndef MK_N_LAUNCHES
#define MK_N_LAUNCHES 1
#endif
__global__ void __launch_bounds__(NTHREADS, 2) mk_fwd(Params P) {
    extern __shared__ __attribute__((aligned(16))) unsigned char lds_raw[];
    LAS unsigned char* lds = (LAS unsigned char*)lds_raw;
    const int tid = threadIdx.x, lane = tid & 63, wave = __builtin_amdgcn_readfirstlane(tid >> 6);
    const int G = gridDim.x, bx = blockIdx.x, vcu = (G % 8 == 0) ? (bx % 8) * (G / 8) + bx / 8 : bx;
    const int lo = P.ph_lo, hi = P.ph_hi;
    if (tid < 64) ((LAS unsigned*)(lds + MISC_OFF))[tid] = 0u;
    __syncthreads();
    XcdBarrier bar = xcd_barrier_post((unsigned*)(P.ws + WS_CTL) + 1024, (volatile LAS unsigned*)(lds + MISC_OFF) + 8);
#define IN(k) (lo <= (k) && (k) < hi)
#define SEAM(k) do { if (IN(k) && IN((k) + 1)) xcd_barrier(bar); } while (0)
    bf16_t* WIN_T = (bf16_t*)(P.ws + WS_WIN); bf16_t* WCAT_T = (bf16_t*)(P.ws + WS_WCAT); bf16_t* WOUT_T = (bf16_t*)(P.ws + WS_WOUT); bf16_t* WPG_T = (bf16_t*)(P.ws + WS_WPG); bf16_t* WPE_T = (bf16_t*)(P.ws + WS_WPE);
    bf16_t* H = (bf16_t*)((unsigned char*)P.out + OUT_H); bf16_t* PB = (bf16_t*)((unsigned char*)P.out + OUT_PB);
    bf16_t* QK = (bf16_t*)(P.ws + WS_QK); bf16_t* ACAT = (bf16_t*)(P.ws + WS_ACAT); bf16_t* SZA = (bf16_t*)(P.ws + WS_SZA); bf16_t* WCX = (bf16_t*)(P.ws + WS_WCX);
    bf16_t* RB = QK;
    bf16_t* SGC = (bf16_t*)((unsigned char*)P.out + 40 * MiB); bf16_t* SGC_HI = (bf16_t*)(P.ws + WS_US + 42 * MiB) - (size_t)12288 * 1024;
    bf16_t* MERGED = SZA; bf16_t* PE = WCX; bf16_t* X2B = QK;
    float* ROWSS2 = (float*)(P.ws + WS_ROWSS2); float* ROWSS3 = (float*)(P.ws + WS_GKLOW);

    unsigned long long ts0_ = 0, ts1_ = 0;
#define TS_MARK(k) do { if (PROBE_TS >= 0) { if ((k) == PROBE_TS) ts0_ = __builtin_amdgcn_s_memrealtime(); if ((k) == PROBE_TS + 1) ts1_ = __builtin_amdgcn_s_memrealtime(); } } while (0)
    TS_MARK(0);
    if (IN(0) && !(SKIPMASK & 1)) { p0_prologue(P, lds, tid, lane, wave, vcu, G); }
    SEAM(0);
    TS_MARK(1);
    if (IN(1) && !(SKIPMASK & 2)) {
        pg8::Gemm g{H, WIN_T, T_TOK, 7168, 1024}; pg8::StaticOrder S; S.init(T_TOK, 7168, G, bx); S.rsh = PROBE_REP_G1A;
        pg8::EpiIn E{QK, ACAT, SZA, WCX, RB, SGC, SGC_HI, P.b_merge, -1};
        pg8::gemm_phase<pg8::EpiIn, pg8::StaticOrder, true, true>(lds, g, S, E);
    }
    SEAM(1);
    TS_MARK(2);
    if (IN(2) && !(SKIPMASK & 4)) { gla_prep(P, lds, tid, lane, wave, vcu, G); }
    SEAM(2);
    TS_MARK(3);
    if (IN(3) && !(SKIPMASK & 8)) {
        if (bx < 64) gla_scan(P, lds, tid, lane, wave, bx & 7, bx >> 3);
        else {
            pg8::Gemm g{H, WIN_T, T_TOK, 9216, 1024}; pg8::GateOrder L{G - 64, bx - 64}; pg8::EpiIn E{QK, ACAT, SZA, WCX, RB, SGC, SGC_HI, P.b_merge, -1};
            pg8::gemm_phase<pg8::EpiIn, pg8::GateOrder, true, true>(lds, g, L, E);
            conv_rows(P, lane, (bx - 64) * NWAVES + wave, (G - 64) * NWAVES);
        }
    }
    SEAM(3);
    TS_MARK(4);
    if (IN(4) && !(SKIPMASK & 16)) { gla_fin(P, lane, vcu * NWAVES + wave, G * NWAVES); }
    SEAM(4);
    TS_MARK(5);
    if (IN(5) && !(SKIPMASK & 32)) {
        { pg8::Gemm g{PB, WPE_T, T_TOK, 1024, 256}; pg8::StaticOrder S; S.init(T_TOK, 1024, G, bx); pg8::EpiPlain E{PE, 1024, -1};
          pg8::gemm_phase<pg8::EpiPlain, pg8::StaticOrder, false, true>(lds, g, S, E); }
        { pg8::Gemm g{ACAT, WCAT_T, T_TOK, 1024, 2048}; pg8::StaticOrder S; S.init(T_TOK, 1024, G, bx); S.rsh = PROBE_REP_P5; pg8::EpiMerge E{RB, SGC, SGC_HI, MERGED, 16};
          pg8::gemm_phase<pg8::EpiMerge, pg8::StaticOrder, false, true>(lds, g, S, E); }
    }
    SEAM(5);
    TS_MARK(6);
    if (IN(6) && !(SKIPMASK & 64)) {
        pg8::Gemm g{MERGED, WOUT_T, T_TOK, 1024, 1024}; pg8::StaticOrder S; S.init(T_TOK, 1024, G, bx); S.rsh = PROBE_REP_P6;
        pg8::EpiOut E{P.x, P.out, X2B, ROWSS2, -1};
        pg8::gemm_phase<pg8::EpiOut, pg8::StaticOrder, false, true>(lds, g, S, E);
    }
    SEAM(6);
    TS_MARK(7);
    if (IN(7) && !(SKIPMASK & 128)) {
        pg8::Gemm g{X2B, WPG_T, T_TOK, 1024, 1024}; pg8::StaticOrder S; S.init(T_TOK, 1024, G, bx);
        pg8::EpiPle E{P.out, PE, ROWSS2, ROWSS3, -1};
        pg8::gemm_phase<pg8::EpiPle, pg8::StaticOrder, false, true>(lds, g, S, E);
    }
    SEAM(7);
    TS_MARK(8);
    if (IN(8) && !(SKIPMASK & 256)) { final_norm(P, lane, vcu * NWAVES + wave, G * NWAVES); }
    TS_MARK(9);
    if (PROBE_TS >= 0 && bx == 0) { const unsigned long long until_ = __builtin_amdgcn_s_memrealtime() + 4ull * (ts1_ - ts0_); while (__builtin_amdgcn_s_memrealtime() < until_) __builtin_amdgcn_s_sleep(8); }
#undef IN
#undef SEAM
}

extern "C" void kernel_launch(void* const* d_in, const int* in_sizes, int n_in, void* d_out, int out_size, void* d_ws, size_t ws_size, hipStream_t stream) {
    static int grid = 0;
    if (grid == 0) {
        if (n_in != 16 || in_sizes[0] != T_TOK * DM || out_size != T_TOK * DM || ws_size < WS_END) { fprintf(stderr, "kernel_launch: unexpected shapes (n_in %d, in0 %d, out %d, ws %zu)\n", n_in, n_in > 0 ? in_sizes[0] : -1, out_size, ws_size); grid = -1; return; }
        int dev = 0, cus = 0, per_cu = 0;
        if (hipGetDevice(&dev) != hipSuccess || hipDeviceGetAttribute(&cus, hipDeviceAttributeMultiprocessorCount, dev) != hipSuccess) { grid = -1; return; }
        if (hipFuncSetAttribute((const void*)mk_fwd, hipFuncAttributeMaxDynamicSharedMemorySize, LDS_BYTES) != hipSuccess) { fprintf(stderr, "kernel_launch: hipFuncSetAttribute failed\n"); grid = -1; return; }
        if (hipOccupancyMaxActiveBlocksPerMultiprocessor(&per_cu, (const void*)mk_fwd, NTHREADS, LDS_BYTES) != hipSuccess || per_cu < 1) { fprintf(stderr, "kernel_launch: occupancy query says %d\n", per_cu); per_cu = 1; }
        (void)hipGetLastError();
        grid = cus;
    }
    if (grid < 0) return;
    if (hipMemsetAsync((char*)d_ws + WS_CTL, 0, 65536, stream) != hipSuccess) { fprintf(stderr, "kernel_launch: hipMemsetAsync failed\n"); return; }
    Params p{};
    const float** dst = (const float**)&p;
    for (int i = 0; i < 16; ++i) dst[i] = (const float*)d_in[i];
    p.out = (float*)d_out; p.ws = (unsigned char*)d_ws;
#if MK_N_LAUNCHES == 1
    p.ph_lo = 0; p.ph_hi = N_PHASES;
    void* args[] = {&p};
    hipError_t e = hipLaunchCooperativeKernel((const void*)mk_fwd, dim3(grid), dim3(NTHREADS), args, LDS_BYTES, stream);
    if (e != hipSuccess) fprintf(stderr, "kernel_launch: cooperative launch failed: %s (grid %d)\n", hipGetErrorString(e), grid);
#else
    for (int ph = 0; ph < N_PHASES; ++ph) { p.ph_lo = ph; p.ph_hi = ph + 1; hipLaunchKernelGGL(mk_fwd, dim3(grid), dim3(NTHREADS), LDS_BYTES, stream, p); }
#endif
}
```

```cpp
#include <hip/hip_runtime.h>
#include <cstdio>
#include <cstdint>
#ifndef PROBE_REP_G1A
#define PROBE_REP_G1A 0
#endif
#ifndef PROBE_REP_PREP
#define PROBE_REP_PREP 0
#endif
#ifndef PROBE_REP_P5
#define PROBE_REP_P5 0
#endif
#ifndef PROBE_REP_P6
#define PROBE_REP_P6 0
#endif
#ifndef PROBE_REP_P0
#define PROBE_REP_P0 0
#endif
#ifndef PROBE_TS
#define PROBE_TS -1
#endif
#ifndef PROBE_REP_P8
#define PROBE_REP_P8 0
#endif
namespace pg8 {
#define PG8_LAS __attribute__((address_space(3)))
typedef unsigned short bf16_t;
typedef short bf16x8 __attribute__((ext_vector_type(8)));
typedef float f32x4 __attribute__((ext_vector_type(4)));
typedef unsigned u32x4 __attribute__((ext_vector_type(4)));
constexpr int BM = 256, BK = 64, HALF = 128, HTB = HALF * BK * 2  , STAGE_BYTES = 8 * HTB, NXCD = 8, WGM = 8;

__host__ __device__ __forceinline__ int lds_byte(int r, int c) { const int st = (r >> 4) * 2 + (c >> 5), rr = r & 15, cc = c & 31, ob = rr * 64 + cc * 2; return st * 1024 + (ob ^ (((ob >> 9) & 1) << 5)); }
__host__ __device__ __forceinline__ void stage_rc(int b, int& R, int& C) { const int st = b / 1024, sb = b % 1024, swz = sb ^ (((sb >> 9) & 1) << 5); R = (st >> 1) * 16 + swz / 64; C = (st & 1) * 32 + (swz % 64) / 2; }
__host__ __device__ __forceinline__ int perm32(int rho) { const int n = rho >> 4, i = rho & 15; return 8 * (i >> 2) + 4 * n + (i & 3); }

struct Unit { int pm, pn; };
struct Gemm { const bf16_t* A; const bf16_t* Bt; int M, N, K; };

struct StaticOrder {
    int nM, nN, nwg, G, c; int rsh = 0;
    __host__ __device__ void init(int M, int N, int G_, int c_) { nM = M / BM; nN = N / BM; nwg = nM * nN; G = G_; c = c_; }
    __host__ __device__ bool next(int i, Unit& u) const {
        const long L = (long)(i >> rsh) * G + c; if (L >= nwg) return false;
        int wgid = (int)L; { const int q = nwg / NXCD, r = nwg % NXCD, xcd = wgid % NXCD, off = wgid / NXCD; wgid = (xcd < r ? xcd * (q + 1) : r * (q + 1) + (xcd - r) * q) + off; }
        const int nig = WGM * nN, gid = wgid / nig, fm = gid * WGM, gsz = (nM - fm) < WGM ? (nM - fm) : WGM;
        u.pm = fm + ((wgid % nig) % gsz); u.pn = (wgid % nig) / gsz; return true;
    }
    __device__ __forceinline__ void a_ready(const Unit&) const {}
    __device__ __forceinline__ void done(const Unit&) const {}
};

__device__ __forceinline__ unsigned cvt_pk_bf16(float lo, float hi) { unsigned r; asm volatile("v_cvt_pk_bf16_f32 %0, %1, %2" : "=v"(r) : "v"(lo), "v"(hi)); return r; }
typedef float f32x2 __attribute__((ext_vector_type(2)));
typedef unsigned u32x2 __attribute__((ext_vector_type(2)));
__device__ __forceinline__ float bf_lo(unsigned w) { return __uint_as_float(w << 16); }
__device__ __forceinline__ float bf_hi(unsigned w) { return __uint_as_float(w & 0xffff0000u); }
__device__ __forceinline__ float fsigmoid(float v) { return __builtin_amdgcn_rcpf(1.f + __expf(-v)); }
__device__ __forceinline__ float fsilu(float v) { return v * __builtin_amdgcn_rcpf(1.f + __expf(-v)); }
__device__ __forceinline__ u32x4 pack8(const f32x4 a, const f32x4 b) { u32x4 w; w.x = cvt_pk_bf16(a[0], a[1]); w.y = cvt_pk_bf16(a[2], a[3]); w.z = cvt_pk_bf16(b[0], b[1]); w.w = cvt_pk_bf16(b[2], b[3]); return w; }
__device__ __forceinline__ void unpack8(const u32x4 w, f32x4& a, f32x4& b) { a = (f32x4){bf_lo(w.x), bf_hi(w.x), bf_lo(w.y), bf_hi(w.y)}; b = (f32x4){bf_lo(w.z), bf_hi(w.z), bf_lo(w.w), bf_hi(w.w)}; }
__device__ __forceinline__ f32x4 silu4(f32x4 v) { return (f32x4){fsilu(v[0]), fsilu(v[1]), fsilu(v[2]), fsilu(v[3])}; }
__device__ __forceinline__ f32x4 sigm4(f32x4 v) { return (f32x4){fsigmoid(v[0]), fsigmoid(v[1]), fsigmoid(v[2]), fsigmoid(v[3])}; }

struct EpiIn {
    static constexpr bool PERM = true, AFTER_DRAIN = false, MIDK = false;
    bf16_t *QK, *ACAT, *SZA, *WCX, *R, *SGC, *SGC_HI; const float* b_merge; int mid_t;
    __device__ __forceinline__ void mid(f32x4 (&)[2][2][4][2], const Unit&, int, int, int, int) const {}
    __device__ __forceinline__ void operator()(const f32x4 (&acc)[2][2][4][2], const Unit& u, int wr, int wc, int fr, int fq) const {
        const int pn = u.pn, row0 = u.pm * BM + wr * 64 + fr, c8 = wc * 32 + 8 * fq;
        __builtin_amdgcn_sched_barrier(0); asm volatile("s_nop 15\n\ts_nop 15\n\ts_nop 15\n\ts_nop 15" ::: "memory"); __builtin_amdgcn_sched_barrier(0);
        if (pn < 12) {
            bf16_t* base; int ldc, colt; const bool act = pn >= 8;
            if (pn < 4) { base = QK; ldc = 1024; colt = pn * 256; } else if (pn < 8) { base = ACAT; ldc = 2048; colt = (pn - 4) * 256; } else { base = SZA; ldc = 1024; colt = (pn - 8) * 256; }
#pragma unroll
            for (int ai = 0; ai < 2; ++ai)
#pragma unroll
                for (int m = 0; m < 4; ++m) { bf16_t* rowp = base + (size_t)(row0 + ai * HALF + m * 16) * ldc + colt + c8;
#pragma unroll
                    for (int bj = 0; bj < 2; ++bj) { f32x4 v0 = acc[ai][bj][m][0], v1 = acc[ai][bj][m][1]; if (act) { v0 = silu4(v0); v1 = silu4(v1); }
                        *(u32x4*)(rowp + bj * HALF) = pack8(v0, v1); } }
        } else if (pn < 28) {
            const bool isw = pn < 20; const int j = isw ? pn - 12 : pn - 20; bf16_t* base = isw ? WCX : ACAT + 1024; const int ldc = isw ? 1024 : 2048;
#pragma unroll
            for (int ai = 0; ai < 2; ++ai)
#pragma unroll
                for (int m = 0; m < 4; ++m) { bf16_t* rowp = base + (size_t)(row0 + ai * HALF + m * 16) * ldc + j * HALF + c8;
                    f32x4 b0 = acc[ai][1][m][0], b1 = acc[ai][1][m][1]; if (!isw) { b0 = silu4(b0); b1 = silu4(b1); }
                    *(u32x4*)rowp = pack8(acc[ai][0][m][0] * b0, acc[ai][0][m][1] * b1); }
        } else {
            const int j = pn - 28, ch = j * HALF + c8;
            const f32x4 ba0 = *(const f32x4*)(b_merge + ch), ba1 = *(const f32x4*)(b_merge + ch + 4), bc0 = *(const f32x4*)(b_merge + 1024 + ch), bc1 = *(const f32x4*)(b_merge + 1024 + ch + 4);
#pragma unroll
            for (int ai = 0; ai < 2; ++ai)
#pragma unroll
                for (int m = 0; m < 4; ++m) { const size_t off = (size_t)(row0 + ai * HALF + m * 16) * 1024 + ch;
                    const f32x4 sa0 = sigm4(acc[ai][0][m][0] + ba0), sa1 = sigm4(acc[ai][0][m][1] + ba1), sc0 = sigm4(acc[ai][1][m][0] + bc0), sc1 = sigm4(acc[ai][1][m][1] + bc1);
                    f32x4 r0, r1;
#pragma unroll
                    for (int e = 0; e < 4; ++e) { r0[e] = sa0[e] * __builtin_amdgcn_rcpf(sc0[e]); r1[e] = sa1[e] * __builtin_amdgcn_rcpf(sc1[e]); }
                    *(u32x4*)(R + off) = pack8(r0, r1); *(u32x4*)((u.pm < 48 ? SGC : SGC_HI) + off) = pack8(sc0, sc1); }
        }
    }
};
struct EpiPlain {
    static constexpr bool PERM = true, AFTER_DRAIN = false, MIDK = false;
    bf16_t* O; int ldc; int mid_t;
    __device__ __forceinline__ void mid(f32x4 (&)[2][2][4][2], const Unit&, int, int, int, int) const {}
    __device__ __forceinline__ void operator()(const f32x4 (&acc)[2][2][4][2], const Unit& u, int wr, int wc, int fr, int fq) const {
        const int row0 = u.pm * BM + wr * 64 + fr, col0 = u.pn * BM + wc * 32 + 8 * fq;
        __builtin_amdgcn_sched_barrier(0); asm volatile("s_nop 15\n\ts_nop 15\n\ts_nop 15\n\ts_nop 15" ::: "memory"); __builtin_amdgcn_sched_barrier(0);
#pragma unroll
        for (int ai = 0; ai < 2; ++ai)
#pragma unroll
            for (int m = 0; m < 4; ++m) { bf16_t* rowp = O + (size_t)(row0 + ai * HALF + m * 16) * ldc + col0;
#pragma unroll
                for (int bj = 0; bj < 2; ++bj) *(u32x4*)(rowp + bj * HALF) = pack8(acc[ai][bj][m][0], acc[ai][bj][m][1]); }
    }
};
struct EpiMerge {
    static constexpr bool PERM = true, AFTER_DRAIN = false, MIDK = true;
    const bf16_t *R, *SGC, *SGC_HI; bf16_t* O; int mid_t;
    __device__ __forceinline__ void mid(f32x4 (&acc)[2][2][4][2], const Unit& u, int wr, int wc, int fr, int fq) const {
        int row0 = u.pm * BM + wr * 64 + fr, col0 = u.pn * BM + wc * 32 + 8 * fq; asm volatile("" : "+v"(row0), "+v"(col0));
#pragma unroll
        for (int ai = 0; ai < 2; ++ai)
#pragma unroll
            for (int m = 0; m < 4; ++m) { const bf16_t* rowp = R + (size_t)(row0 + ai * HALF + m * 16) * 1024 + col0;
#pragma unroll
                for (int bj = 0; bj < 2; ++bj) { f32x4 r0, r1; unpack8(*(const u32x4*)(rowp + bj * HALF), r0, r1); acc[ai][bj][m][0] *= r0; acc[ai][bj][m][1] *= r1; }
                if (m & 1) asm volatile("" ::: "memory"); }
    }
    __device__ __forceinline__ void operator()(const f32x4 (&acc)[2][2][4][2], const Unit& u, int wr, int wc, int fr, int fq) const {
        const int row0 = u.pm * BM + wr * 64 + fr, col0 = u.pn * BM + wc * 32 + 8 * fq;
#pragma unroll
        for (int ai = 0; ai < 2; ++ai)
#pragma unroll
            for (int m = 0; m < 4; ++m) { const size_t off = (size_t)(row0 + ai * HALF + m * 16) * 1024 + col0;
#pragma unroll
                for (int bj = 0; bj < 2; ++bj) { f32x4 s0, s1; unpack8(*(const u32x4*)((u.pm < 48 ? SGC : SGC_HI) + off + bj * HALF), s0, s1);
                    *(u32x4*)(O + off + bj * HALF) = pack8(acc[ai][bj][m][0] * s0, acc[ai][bj][m][1] * s1); }
                if (m & 1) asm volatile("" ::: "memory"); }
    }
};
struct EpiOut {
    static constexpr bool PERM = false, AFTER_DRAIN = false, MIDK = false;
    const float* x; float* x2; bf16_t* x2b; float* rowss; int mid_t;
    __device__ __forceinline__ void mid(f32x4 (&)[2][2][4][2], const Unit&, int, int, int, int) const {}
    __device__ __forceinline__ void operator()(const f32x4 (&acc)[2][2][4][2], const Unit& u, int wr, int wc, int fr, int fq) const {
        const int col0 = u.pn * BM + wc * 32 + 4 * fq;
#pragma unroll
        for (int ai = 0; ai < 2; ++ai)
#pragma unroll
            for (int m = 0; m < 4; ++m) { const int row = u.pm * BM + ai * HALF + wr * 64 + m * 16 + fr; const size_t off = (size_t)row * 1024 + col0; float s = 0.f;
#pragma unroll
                for (int bj = 0; bj < 2; ++bj)
#pragma unroll
                    for (int n = 0; n < 2; ++n) { const size_t c = off + bj * HALF + n * 16; const f32x4 o = *(const f32x4*)(x + c) + acc[ai][bj][m][n];
                        *(f32x4*)(x2 + c) = o; u32x2 w; w.x = cvt_pk_bf16(o[0], o[1]); w.y = cvt_pk_bf16(o[2], o[3]); *(u32x2*)(x2b + c) = w;
                        s += (o[0] * o[0] + o[1] * o[1]) + (o[2] * o[2] + o[3] * o[3]); }
                s += __shfl_xor(s, 16); s += __shfl_xor(s, 32);
                if (fq == 0) rowss[(size_t)row * 16 + u.pn * 4 + wc] = s;
                asm volatile("" ::: "memory"); }
    }
};
struct EpiPle {
    static constexpr bool PERM = false, AFTER_DRAIN = false, MIDK = false;
    float* xio; const bf16_t* pe; const float* rowss2; float* rowss3; int mid_t;
    __device__ __forceinline__ void mid(f32x4 (&)[2][2][4][2], const Unit&, int, int, int, int) const {}
    __device__ __forceinline__ void operator()(const f32x4 (&acc)[2][2][4][2], const Unit& u, int wr, int wc, int fr, int fq) const {
        const int col0 = u.pn * BM + wc * 32 + 4 * fq;
#pragma unroll
        for (int ai = 0; ai < 2; ++ai)
#pragma unroll
            for (int m = 0; m < 4; ++m) { const int row = u.pm * BM + ai * HALF + wr * 64 + m * 16 + fr; const size_t off = (size_t)row * 1024 + col0;
                const f32x4* rs = (const f32x4*)(rowss2 + (size_t)row * 16); const f32x4 q0 = rs[0], q1 = rs[1], q2 = rs[2], q3 = rs[3];
                const float ss = ((q0[0] + q0[1]) + (q0[2] + q0[3])) + ((q1[0] + q1[1]) + (q1[2] + q1[3])) + ((q2[0] + q2[1]) + (q2[2] + q2[3])) + ((q3[0] + q3[1]) + (q3[2] + q3[3]));
                const float rstd = __builtin_amdgcn_rsqf(ss * (1.f / 1024.f) + 1e-6f); float s = 0.f;
#pragma unroll
                for (int bj = 0; bj < 2; ++bj)
#pragma unroll
                    for (int n = 0; n < 2; ++n) { const size_t c = off + bj * HALF + n * 16; const f32x4 g = sigm4(acc[ai][bj][m][n] * rstd); const u32x2 pw = *(const u32x2*)(pe + c);
                        const f32x4 pv = (f32x4){bf_lo(pw.x), bf_hi(pw.x), bf_lo(pw.y), bf_hi(pw.y)}; const f32x4 o = *(const f32x4*)(xio + c) + g * pv;
                        *(f32x4*)(xio + c) = o; s += (o[0] * o[0] + o[1] * o[1]) + (o[2] * o[2] + o[3] * o[3]); }
                s += __shfl_xor(s, 16); s += __shfl_xor(s, 32);
                if (fq == 0) rowss3[(size_t)row * 16 + u.pn * 4 + wc] = s;
                asm volatile("" ::: "memory"); }
    }
};
struct PairOrder { StaticOrder S;
    __device__ __forceinline__ bool next(int i, Unit& u) const { Unit m; if (!S.next(i >> 1, m)) return false; u.pm = m.pm; u.pn = 28 + 2 * m.pn + (i & 1); return true; }
    __device__ __forceinline__ void a_ready(const Unit&) const {}
    __device__ __forceinline__ void done(const Unit&) const {}
};
struct GateOrder { int Gs, c;
    __device__ __forceinline__ bool next(int i, Unit& u) const { const int L = i * Gs + c; if (L >= 512) return false; u.pm = L >> 3; u.pn = 28 + (L & 7); return true; }
    __device__ __forceinline__ void a_ready(const Unit&) const {}
    __device__ __forceinline__ void done(const Unit&) const {}
};
struct ListOrder {
    int pm, pn0, cnt;
    __device__ __forceinline__ bool next(int i, Unit& u) const { if (i >= cnt) return false; u.pm = pm; u.pn = pn0 + i; return true; }
    __device__ __forceinline__ void a_ready(const Unit&) const {}
    __device__ __forceinline__ void done(const Unit&) const {}
};
template <class Epi, class Sched, bool ALIGN_EPI = false, bool SP2 = false>
__device__ __forceinline__ void gemm_phase(PG8_LAS unsigned char* lds, const Gemm g, const Sched& S, const Epi& E) {
    const int tid = threadIdx.x, wid = __builtin_amdgcn_readfirstlane(tid >> 6), lane = tid & 63, wr = wid >> 2, wc = wid & 3, fr = lane & 15, fq = lane >> 4;
    const int K = g.K, nt = K / BK;
    unsigned voffA[2], voffB[2];
#pragma unroll
    for (int i = 0; i < 2; ++i) { int R, C; stage_rc(tid * 16 + i * 8192, R, C); const int Rb = Epi::PERM ? ((R & ~31) + perm32(R & 31)) : R;
        voffA[i] = (unsigned)(R * K + C) * 2u; voffB[i] = (unsigned)(Rb * K + C) * 2u; }
    const size_t kstep = (size_t)(BK * 2);
    const size_t hstep = (size_t)HALF * K * 2;
    const size_t tstep = 2 * hstep;
    const unsigned ldsw = (unsigned)wid * 1024u;
    const int aoff = lds_byte(wr * 64 + fr, fq * 8), boff = lds_byte(wc * 32 + fr, fq * 8);
#define PG8_SA(b, h) (((b) * 2 + (h)) * HTB)
#define PG8_SB(b, h) ((4 + (b) * 2 + (h)) * HTB)
#define PG8_STAGE(bufoff, gbase, voff) do { _Pragma("unroll") for (int _i = 0; _i < 2; ++_i) \
        __builtin_amdgcn_global_load_lds((const unsigned*)((const char*)(gbase) + (voff)[_i]), (PG8_LAS unsigned*)(lds + (bufoff) + ldsw + _i * 8192), 16, 0, 0); } while (0)
#define PG8_LDA(dst, b, h) do { _Pragma("unroll") for (int m = 0; m < 4; ++m) _Pragma("unroll") for (int k = 0; k < 2; ++k) dst[m][k] = *(const PG8_LAS bf16x8*)(lds + PG8_SA(b, h) + aoff + m * 2048 + k * 1024); } while (0)
#define PG8_LDB(dst, b, h) do { _Pragma("unroll") for (int n = 0; n < 2; ++n) _Pragma("unroll") for (int k = 0; k < 2; ++k) dst[n][k] = *(const PG8_LAS bf16x8*)(lds + PG8_SB(b, h) + boff + n * 2048 + k * 1024); } while (0)
#define PG8_MMA(ai, bj, At, Bt) do { __builtin_amdgcn_s_setprio(1); _Pragma("unroll") for (int m = 0; m < 4; ++m) _Pragma("unroll") for (int n = 0; n < 2; ++n) _Pragma("unroll") for (int k = 0; k < 2; ++k) \
        acc[ai][bj][m][n] = __builtin_amdgcn_mfma_f32_16x16x32_bf16(Bt[n][k], At[m][k], acc[ai][bj][m][n], 0, 0, 0); __builtin_amdgcn_s_setprio(0); } while (0)
#define PG8_WAIT_V(n) asm volatile("s_waitcnt vmcnt(" #n ")" ::: "memory")
#define PG8_WAIT_L(n) asm volatile("s_waitcnt lgkmcnt(" #n ")" ::: "memory")
#define PG8_BAR __builtin_amdgcn_s_barrier()
#define PG8_SCHED __builtin_amdgcn_sched_barrier(0)
    Unit cur, nxt; int ui = 0;
    if (!S.next(0, cur)) return;
    f32x4 acc[2][2][4][2];
#pragma unroll
    for (int a = 0; a < 2; ++a)
#pragma unroll
        for (int b = 0; b < 2; ++b)
#pragma unroll
            for (int m = 0; m < 4; ++m)
#pragma unroll
                for (int n = 0; n < 2; ++n) acc[a][b][m][n] = (f32x4){0.f, 0.f, 0.f, 0.f};
    bf16x8 At[4][2], B0[2][2], B1[2][2];
    const char* cA = (const char*)g.A + (size_t)cur.pm * tstep; const char* cB = (const char*)g.Bt + (size_t)cur.pn * tstep;
    S.a_ready(cur);
    if constexpr (SP2) {
        PG8_STAGE(PG8_SB(0, 0), cB, voffB); PG8_STAGE(PG8_SB(0, 1), cB + hstep, voffB); PG8_STAGE(PG8_SA(0, 0), cA, voffA); PG8_STAGE(PG8_SA(0, 1), cA + hstep, voffA);
        if (wr == 1) PG8_BAR;
        PG8_WAIT_V(2); PG8_BAR;
        PG8_STAGE(PG8_SB(1, 0), cB + kstep, voffB); PG8_STAGE(PG8_SA(1, 0), cA + kstep, voffA); PG8_STAGE(PG8_SB(1, 1), cB + hstep + kstep, voffB);
        PG8_WAIT_V(6); PG8_BAR;
    } else {
        PG8_STAGE(PG8_SB(0, 0), cB, voffB); PG8_STAGE(PG8_SA(0, 0), cA, voffA); PG8_STAGE(PG8_SB(0, 1), cB + hstep, voffB); PG8_STAGE(PG8_SA(0, 1), cA + hstep, voffA);
        if (wr == 1) PG8_BAR;
        PG8_WAIT_V(4); PG8_BAR;
        PG8_STAGE(PG8_SB(1, 0), cB + kstep, voffB); PG8_STAGE(PG8_SA(1, 0), cA + kstep, voffA); PG8_STAGE(PG8_SB(1, 1), cB + hstep + kstep, voffB);
        PG8_WAIT_V(6); PG8_BAR;
    }
    for (;;) {
        const bool has_next = S.next(ui + 1, nxt);
        const char* nA = has_next ? (const char*)g.A + (size_t)nxt.pm * tstep : cA; const char* nB = has_next ? (const char*)g.Bt + (size_t)nxt.pn * tstep : cB;
        for (int t = 0; t < nt; t += 2) {
            if constexpr (Epi::MIDK) { if (t == E.mid_t) E.mid(acc, cur, wr, wc, fr, fq); }
            const bool last = (t == nt - 2);
            const char* a1 = cA + (size_t)(t + 1) * kstep;
            const char* a2 = last ? nA : cA + (size_t)(t + 2) * kstep; const char* b2 = last ? nB : cB + (size_t)(t + 2) * kstep;
            const char* a3 = a2 + kstep; const char* b3 = b2 + kstep;
            if (last && has_next) S.a_ready(nxt);
            if constexpr (SP2) {
            PG8_LDB(B0, 0, 0); PG8_LDB(B1, 0, 1); PG8_SCHED; PG8_LDA(At, 0, 0); PG8_STAGE(PG8_SA(1, 1), a1 + hstep, voffA);
            PG8_WAIT_V(8); PG8_WAIT_L(0); PG8_BAR; PG8_MMA(0, 0, At, B0); PG8_MMA(0, 1, At, B1); PG8_BAR; PG8_SCHED;
            PG8_LDA(At, 0, 1); PG8_STAGE(PG8_SB(0, 0), b2, voffB); PG8_STAGE(PG8_SB(0, 1), b2 + hstep, voffB); PG8_STAGE(PG8_SA(0, 0), a2, voffA);
            PG8_WAIT_V(8); PG8_WAIT_L(0); PG8_BAR; PG8_MMA(1, 0, At, B0); PG8_MMA(1, 1, At, B1); PG8_BAR; PG8_SCHED;
            PG8_LDB(B0, 1, 0); PG8_LDB(B1, 1, 1); PG8_SCHED; PG8_LDA(At, 1, 0); PG8_STAGE(PG8_SA(0, 1), a2 + hstep, voffA);
            PG8_WAIT_V(8); PG8_WAIT_L(0); PG8_BAR; PG8_MMA(0, 0, At, B0); PG8_MMA(0, 1, At, B1); PG8_BAR; PG8_SCHED;
            PG8_LDA(At, 1, 1); PG8_STAGE(PG8_SB(1, 0), b3, voffB); PG8_STAGE(PG8_SB(1, 1), b3 + hstep, voffB); PG8_STAGE(PG8_SA(1, 0), a3, voffA);
            PG8_WAIT_V(8); PG8_WAIT_L(0); PG8_BAR; PG8_MMA(1, 0, At, B0); PG8_MMA(1, 1, At, B1); PG8_BAR; PG8_SCHED;
            } else {
            PG8_LDB(B0, 0, 0); PG8_SCHED; PG8_LDA(At, 0, 0); PG8_STAGE(PG8_SA(1, 1), a1 + hstep, voffA);
            PG8_WAIT_L(8); PG8_BAR; PG8_WAIT_L(0); PG8_MMA(0, 0, At, B0); PG8_BAR; PG8_SCHED;
            PG8_LDB(B1, 0, 1); PG8_STAGE(PG8_SB(0, 0), b2, voffB);
            PG8_BAR; PG8_WAIT_L(0); PG8_MMA(0, 1, At, B1); PG8_BAR;
            PG8_LDA(At, 0, 1); PG8_STAGE(PG8_SA(0, 0), a2, voffA);
            PG8_BAR; PG8_WAIT_L(0); PG8_MMA(1, 0, At, B0); PG8_BAR; PG8_SCHED;
            PG8_STAGE(PG8_SB(0, 1), b2 + hstep, voffB);
            PG8_WAIT_V(6); PG8_BAR; PG8_MMA(1, 1, At, B1); PG8_BAR;
            PG8_LDB(B0, 1, 0); PG8_SCHED; PG8_LDA(At, 1, 0); PG8_STAGE(PG8_SA(0, 1), a2 + hstep, voffA);
            PG8_WAIT_L(8); PG8_BAR; PG8_WAIT_L(0); PG8_MMA(0, 0, At, B0); PG8_BAR; PG8_SCHED;
            PG8_LDB(B1, 1, 1); PG8_STAGE(PG8_SB(1, 0), b3, voffB);
            PG8_BAR; PG8_WAIT_L(0); PG8_MMA(0, 1, At, B1); PG8_BAR;
            PG8_LDA(At, 1, 1); PG8_STAGE(PG8_SA(1, 0), a3, voffA);
            PG8_BAR; PG8_WAIT_L(0); PG8_MMA(1, 0, At, B0); PG8_BAR; PG8_SCHED;
            PG8_STAGE(PG8_SB(1, 1), b3 + hstep, voffB);
            PG8_WAIT_V(6); PG8_BAR; PG8_MMA(1, 1, At, B1); PG8_BAR;
            }
        }
        if constexpr (ALIGN_EPI) { if (wr == 0) PG8_BAR; }
        if constexpr (!Epi::AFTER_DRAIN) { E(acc, cur, wr, wc, fr, fq); S.done(cur); }
        if (!has_next) break;
#pragma unroll
        for (int a = 0; a < 2; ++a)
#pragma unroll
            for (int b = 0; b < 2; ++b)
#pragma unroll
                for (int m = 0; m < 4; ++m)
#pragma unroll
                    for (int n = 0; n < 2; ++n) acc[a][b][m][n] = (f32x4){0.f, 0.f, 0.f, 0.f};
        cur = nxt; cA = nA; cB = nB; ++ui;
        if constexpr (ALIGN_EPI) { if (wr == 1) PG8_BAR; }
    }
    PG8_WAIT_V(0);
    if constexpr (!ALIGN_EPI) { if (wr == 0) PG8_BAR; }
    PG8_BAR;
    if constexpr (Epi::AFTER_DRAIN) { E.fused(acc, cur, wr, wc, fr, fq, lds, wid, lane); S.done(cur); }
#undef PG8_SA
#undef PG8_SB
#undef PG8_STAGE
#undef PG8_LDA
#undef PG8_LDB
#undef PG8_MMA
#undef PG8_WAIT_V
#undef PG8_WAIT_L
#undef PG8_BAR
#undef PG8_SCHED
}
}

constexpr int T_TOK = 16384, SEQ = 8192, DM = 1024, IN_COLS = 9232, NCHUNK = SEQ / 64;
constexpr float EPS = 1e-6f;
constexpr int NWAVES = 8, NTHREADS = 512;
constexpr size_t MiB = 1u << 20;
constexpr size_t WS_CTL = 0, CTL_ZERO_BYTES = 1 * MiB;
constexpr size_t WS_WIN = 1 * MiB;
constexpr size_t WS_GKLOW = 19 * MiB;
constexpr size_t WS_DECAY = 20 * MiB;
constexpr size_t WS_ROWSS2 = 21 * MiB;
constexpr size_t WS_QK = 22 * MiB;
constexpr size_t WS_ACAT = 54 * MiB;
constexpr size_t WS_SZA = 118 * MiB;
constexpr size_t WS_WCX = 150 * MiB;
constexpr size_t WS_US = 182 * MiB;
constexpr size_t WS_WCAT = 246 * MiB;
constexpr size_t WS_WOUT = 250 * MiB;
constexpr size_t WS_WPG = 252 * MiB;
constexpr size_t WS_WPE = 254 * MiB;
constexpr size_t WS_END = 256 * MiB;
constexpr size_t OUT_H = 0, OUT_PB = 32 * MiB, OUT_AMAT = 40 * MiB;
constexpr int RING_BYTES = 131072, LDS_BYTES = 163840, MISC_OFF = LDS_BYTES - 256;

#define LAS __attribute__((address_space(3)))
typedef unsigned short bf16_t;
typedef float f32x4 __attribute__((ext_vector_type(4)));
typedef unsigned u32x4 __attribute__((ext_vector_type(4)));
typedef unsigned u32x2 __attribute__((ext_vector_type(2)));
using pg8::cvt_pk_bf16; using pg8::bf_lo; using pg8::bf_hi;
#define LDS_WAIT() asm volatile("s_waitcnt lgkmcnt(0)" ::: "memory")
__device__ __forceinline__ float bf2f(bf16_t v) { return __uint_as_float((unsigned)v << 16); }
__device__ __forceinline__ float wave_sum(float v) {
#pragma unroll
    for (int o = 1; o < 64; o <<= 1) v += __shfl_xor(v, o);
    return v;
}

struct Params {
    const float *x, *p, *norm_mix_g, *w_in, *b_merge, *w_gk2, *b_gk, *gla_norm_g, *conv_w, *w_a, *w_c, *w_out, *norm_ple_g, *w_pg, *w_pe, *norm_final_g;
    float* out; unsigned char* ws; int ph_lo, ph_hi;
};

__device__ __forceinline__ void transpose_item(const float* src, int srcN, int col0, int k0, bf16_t* dst, int dstK, int drow0, int dk0, const float* kscale, LAS float* scr, int lane) {
#pragma unroll 8
    for (int i = 0; i < 32; ++i) { const int kk = 2 * i + (lane >> 5); float v = src[(size_t)(k0 + kk) * srcN + col0 + (lane & 31)]; if (kscale) v *= kscale[k0 + kk]; scr[kk * 33 + (lane & 31)] = v; }
    LDS_WAIT(); asm volatile("" ::: "memory");
    const int c = lane & 7;
#pragma unroll
    for (int j = 0; j < 4; ++j) { const int n = (lane >> 3) + 8 * j; const LAS float* s = scr + (8 * c) * 33 + n;
        u32x4 o; o.x = cvt_pk_bf16(s[0 * 33], s[1 * 33]); o.y = cvt_pk_bf16(s[2 * 33], s[3 * 33]); o.z = cvt_pk_bf16(s[4 * 33], s[5 * 33]); o.w = cvt_pk_bf16(s[6 * 33], s[7 * 33]);
        *(u32x4*)(dst + (size_t)(drow0 + n) * dstK + dk0 + k0 + 8 * c) = o; }
    LDS_WAIT(); asm volatile("" ::: "memory");
}
__device__ __forceinline__ int win_colmap(int np) {
    const int tile = np >> 8, r = np & 255;
    if (tile < 12) return np;
    if (tile < 20) { const int j = tile - 12; return r < 128 ? 4112 + 128 * j + r : 5136 + 128 * j + (r - 128); }
    if (tile < 28) { const int j = tile - 20; return r < 128 ? 3088 + 128 * j + r : 6160 + 128 * j + (r - 128); }
    const int j = tile - 28; return r < 128 ? 7184 + 128 * j + r : 8208 + 128 * j + (r - 128);
}
__device__ __forceinline__ void p0_prologue(const Params& P, LAS unsigned char* lds, int tid, int lane, int wave, int vcu, int G) {
    bf16_t* WIN_T = (bf16_t*)(P.ws + WS_WIN); bf16_t* WCAT_T = (bf16_t*)(P.ws + WS_WCAT); bf16_t* WOUT_T = (bf16_t*)(P.ws + WS_WOUT); bf16_t* WPG_T = (bf16_t*)(P.ws + WS_WPG); bf16_t* WPE_T = (bf16_t*)(P.ws + WS_WPE);
    bf16_t* H = (bf16_t*)((unsigned char*)P.out + OUT_H); bf16_t* PB = (bf16_t*)((unsigned char*)P.out + OUT_PB); float* GKLOW = (float*)(P.ws + WS_GKLOW);
    LAS float* scr = (LAS float*)(lds + wave * 16384);
    const int gw = vcu * NWAVES + wave, NGW = G * NWAVES;
    constexpr int I_IN = 16 * 288, I_SQ = 16 * 32, I_PE = 4 * 32, NITEMS = I_IN + 4 * I_SQ + I_PE;
    for (int it = gw; it < (NITEMS << PROBE_REP_P0); it += NGW) {
        int r = it >= NITEMS ? it - NITEMS : it;
        if (r < I_IN) { const int kb = r / 288, nb = r % 288; transpose_item(P.w_in, IN_COLS, win_colmap(32 * nb), 64 * kb, WIN_T, 1024, 32 * nb, 0, nullptr, scr, lane); continue; } r -= I_IN;
        const int kb = r / 32 % 16, nb = r % 32, which = r / I_SQ;
        if (which == 0) transpose_item(P.w_a, 1024, 32 * nb, 64 * kb, WCAT_T, 2048, 32 * nb, 0, nullptr, scr, lane);
        else if (which == 1) transpose_item(P.w_c, 1024, 32 * nb, 64 * kb, WCAT_T, 2048, 32 * nb, 1024, nullptr, scr, lane);
        else if (which == 2) transpose_item(P.w_out, 1024, 32 * nb, 64 * kb, WOUT_T, 1024, 32 * nb, 0, nullptr, scr, lane);
        else if (which == 3) transpose_item(P.w_pg, 1024, 32 * nb, 64 * kb, WPG_T, 1024, 32 * nb, 0, P.norm_ple_g, scr, lane);
        else { const int r2 = r - 4 * I_SQ; transpose_item(P.w_pe, 1024, 32 * (r2 % 32), 64 * (r2 / 32), WPE_T, 256, 32 * (r2 % 32), 0, nullptr, scr, lane); }
    }
    for (int ee = vcu * NTHREADS + tid; ee < ((T_TOK * 256 / 8) << PROBE_REP_P0); ee += G * NTHREADS) { const int e = ee & (T_TOK * 256 / 8 - 1); const f32x4 a = *(const f32x4*)(P.p + (size_t)e * 8), b = *(const f32x4*)(P.p + (size_t)e * 8 + 4);
        *(u32x4*)(PB + (size_t)e * 8) = pg8::pack8(a, b); }
    __syncthreads();
    LAS float* WgT = (LAS float*)lds;
    for (int e = tid; e < 16 * 1024; e += NTHREADS) { const int k = e >> 4, c = e & 15; WgT[c * 1024 + k] = P.w_in[(size_t)k * IN_COLS + 3072 + c]; }
    __syncthreads();
    f32x4 gv[4];
#pragma unroll
    for (int j = 0; j < 4; ++j) gv[j] = *(const f32x4*)(P.norm_mix_g + 4 * lane + 256 * j);
    for (int prr = gw; prr < ((T_TOK / 2) << PROBE_REP_P0); prr += NGW) { const int pr = prr & (T_TOK / 2 - 1);
        f32x4 hv[2][4];
#pragma unroll
        for (int r = 0; r < 2; ++r) { const float* xr = P.x + (size_t)(2 * pr + r) * DM; float ss = 0.f;
#pragma unroll
            for (int j = 0; j < 4; ++j) { hv[r][j] = *(const f32x4*)(xr + 4 * lane + 256 * j); ss += (hv[r][j][0] * hv[r][j][0] + hv[r][j][1] * hv[r][j][1]) + (hv[r][j][2] * hv[r][j][2] + hv[r][j][3] * hv[r][j][3]); }
            const float rstd = 1.0f / sqrtf(wave_sum(ss) * (1.f / DM) + EPS);
            bf16_t* hr = H + (size_t)(2 * pr + r) * DM;
#pragma unroll
            for (int j = 0; j < 4; ++j) { hv[r][j] = hv[r][j] * rstd * gv[j]; u32x2 w; w.x = cvt_pk_bf16(hv[r][j][0], hv[r][j][1]); w.y = cvt_pk_bf16(hv[r][j][2], hv[r][j][3]); *(u32x2*)(hr + 4 * lane + 256 * j) = w; } }
        float a[32];
#pragma unroll
        for (int c = 0; c < 16; ++c) { float s0 = 0.f, s1 = 0.f;
#pragma unroll
            for (int j = 0; j < 4; ++j) { const f32x4 w = *(const LAS f32x4*)(WgT + c * 1024 + 4 * lane + 256 * j);
                s0 += (hv[0][j][0] * w[0] + hv[0][j][1] * w[1]) + (hv[0][j][2] * w[2] + hv[0][j][3] * w[3]); s1 += (hv[1][j][0] * w[0] + hv[1][j][1] * w[1]) + (hv[1][j][2] * w[2] + hv[1][j][3] * w[3]); }
            a[c] = s0; a[16 + c] = s1; }
#pragma unroll
        for (int o = 32, n = 16; n >= 1; o >>= 1, n >>= 1) { const bool up = (lane & o) != 0;
#pragma unroll
            for (int i = 0; i < n; ++i) { const float send = up ? a[i] : a[i + n], keep = up ? a[i + n] : a[i]; a[i] = keep + __shfl_xor(send, o); } }
        a[0] += __shfl_xor(a[0], 1);
        if ((lane & 1) == 0) { const int idx = lane >> 1; GKLOW[(size_t)(2 * pr + (idx >> 4)) * 16 + (idx & 15)] = a[0]; }
    }
}

typedef short bf16x8 __attribute__((ext_vector_type(8)));
typedef float f32x16 __attribute__((ext_vector_type(16)));
constexpr int REC_BYTES = 43008, REC_QI = 0, REC_KDT = 16384, REC_AM = 32768, REC_DEC = 40960;
__device__ __forceinline__ int img256(int row, int col) { return row * 256 + ((((col >> 3) ^ (row & 15))) << 4) + (col & 7) * 2; }
__device__ __forceinline__ int img128(int row, int col) { return row * 128 + ((((col >> 3) ^ ((row >> 1) & 7))) << 4) + (col & 7) * 2; }
typedef float f32x2c __attribute__((ext_vector_type(2))); typedef __bf16 bf16x2c __attribute__((ext_vector_type(2)));
__device__ __forceinline__ unsigned cvt_pk_c(float lo, float hi) { const f32x2c v = {lo, hi}; const bf16x2c b = __builtin_convertvector(v, bf16x2c); return __builtin_bit_cast(unsigned, b); }
__device__ __forceinline__ bf16_t f2bf(float v) { return (bf16_t)(cvt_pk_c(v, 0.f) & 0xffffu); }
__device__ __forceinline__ bf16x8 lds_frag(LAS unsigned char* p) { return *(LAS bf16x8*)p; }

__device__ __forceinline__ void gla_prep(const Params& P, LAS unsigned char* lds, int tid, int lane, int wave, int vcu, int G) {
    const bf16_t* QK = (const bf16_t*)(P.ws + WS_QK); const float* GKLOW = (const float*)(P.ws + WS_GKLOW); unsigned char* REC = P.ws + WS_US;
    LAS float* gl = (LAS float*)lds; LAS float* tot = (LAS float*)(lds + 4096); LAS unsigned char* Qi = lds + 8192; LAS unsigned char* Ki = lds + 24576; LAS unsigned char* Am = lds + 40960;
    const int d = tid & 127, tg = tid >> 7, r32 = lane & 31, hh = lane >> 5;
    for (int uu = vcu; uu < (1024 << PROBE_REP_PREP); uu += G) { const int u = uu & 1023;
        const int h = u & 3, n = (u >> 2) & 127, b = u >> 9, t0 = b * SEQ + n * 64;
        unsigned char* rec = REC + (size_t)u * REC_BYTES;
        for (int e = tid; e < 1024; e += NTHREADS) gl[e] = GKLOW[(size_t)t0 * 16 + e];
        float qv[16], kv[16], w2[16];
#pragma unroll
        for (int i = 0; i < 16; ++i) { const size_t t = (size_t)(t0 + 16 * tg + i); qv[i] = bf2f(QK[t * 1024 + h * 128 + d]); kv[i] = bf2f(QK[t * 1024 + 512 + h * 128 + d]); }
#pragma unroll
        for (int r = 0; r < 16; ++r) w2[r] = P.w_gk2[r * 512 + h * 128 + d];
        const float bias = P.b_gk[h * 128 + d];
        __syncthreads();
        float c[16]; float run = 0.f;
#pragma unroll
        for (int i = 0; i < 16; ++i) { float z = bias;
#pragma unroll
            for (int r4 = 0; r4 < 4; ++r4) { const f32x4 g4 = *(const LAS f32x4*)(gl + (16 * tg + i) * 16 + 4 * r4); z += (g4[0] * w2[4 * r4] + g4[1] * w2[4 * r4 + 1]) + (g4[2] * w2[4 * r4 + 2] + g4[3] * w2[4 * r4 + 3]); }
            const float gk = (fminf(z, 0.f) - __logf(1.f + __expf(-fabsf(z)))) * (1.f / 16.f); run += gk; c[i] = run; }
        tot[tg * 128 + d] = run;
        __syncthreads();
        float off = 0.f, total = 0.f;
#pragma unroll
        for (int g = 0; g < 4; ++g) { const float v = tot[g * 128 + d]; total += v; if (g < tg) off += v; }
        float kd[16];
#pragma unroll
        for (int i = 0; i < 16; ++i) { const float bb = off + c[i]; const int t = 16 * tg + i;
            *(LAS bf16_t*)(Qi + img256(t, d)) = f2bf(qv[i] * 0.08838834764831845f * __expf(bb));
            *(LAS bf16_t*)(Ki + img256(t, d)) = f2bf(kv[i] * __expf(-bb));
            kd[i] = kv[i] * __expf(total - bb); }
        {
            u32x4 w0, w1; w0.x = cvt_pk_bf16(kd[0], kd[1]); w0.y = cvt_pk_bf16(kd[2], kd[3]); w0.z = cvt_pk_bf16(kd[4], kd[5]); w0.w = cvt_pk_bf16(kd[6], kd[7]);
            w1.x = cvt_pk_bf16(kd[8], kd[9]); w1.y = cvt_pk_bf16(kd[10], kd[11]); w1.z = cvt_pk_bf16(kd[12], kd[13]); w1.w = cvt_pk_bf16(kd[14], kd[15]);
            *(u32x4*)(rec + REC_KDT + img128(d, 16 * tg)) = w0; *(u32x4*)(rec + REC_KDT + img128(d, 16 * tg + 8)) = w1; }
        if (tg == 0) ((float*)(rec + REC_DEC))[d] = __expf(total);
        __syncthreads();
        if (wave < 4) {
            const int mi = wave >> 1, nj = wave & 1, ra = 32 * mi + r32, rb = 32 * nj + r32;
            f32x16 acc;
#pragma unroll
            for (int e = 0; e < 16; ++e) acc[e] = 0.f;
#pragma unroll
            for (int s = 0; s < 8; ++s) { const bf16x8 a = lds_frag(Qi + ra * 256 + ((((2 * s + hh) ^ (ra & 15))) << 4)), bq = lds_frag(Ki + rb * 256 + ((((2 * s + hh) ^ (rb & 15))) << 4));
                acc = __builtin_amdgcn_mfma_f32_32x32x16_bf16(a, bq, acc, 0, 0, 0); }
            const int j = 32 * nj + r32;
#pragma unroll
            for (int e = 0; e < 16; ++e) { const int i = 32 * mi + (e & 3) + 8 * (e >> 2) + 4 * hh; *(LAS bf16_t*)(Am + img128(i, j)) = f2bf(j <= i ? acc[e] : 0.f); }
        }
#pragma unroll
        for (int k = 0; k < 2; ++k) { const int ch = tid + NTHREADS * k; *(u32x4*)(rec + REC_QI + ch * 16) = *(LAS u32x4*)(Qi + ch * 16); }
        __syncthreads();
        *(u32x4*)(rec + REC_AM + tid * 16) = *(LAS u32x4*)(Am + tid * 16);
        __syncthreads();
    }
}

typedef short s16x4 __attribute__((ext_vector_type(4)));
__device__ __forceinline__ s16x4 lds_tr(LAS unsigned char* p) { return __builtin_bit_cast(s16x4, __builtin_amdgcn_ds_read_tr16_b64_v4i16((LAS s16x4*)p)); }
__device__ __forceinline__ void gla_scan(const Params& P, LAS unsigned char* lds, int tid, int lane, int wave, int bh, int dvs) {
    const unsigned char* REC = P.ws + WS_US; bf16_t* ACAT = (bf16_t*)(P.ws + WS_ACAT); bf16_t* O = ACAT;
    constexpr int BUF = 47104, B_QI = 0, B_KDT = 16384, B_AM = 32768, B_DEC = 40960, B_VT = 43008, ST0 = 3 * BUF, ST_BYTES = 8192;
    static_assert(ST0 + 2 * ST_BYTES <= MISC_OFF && REC_BYTES == 7 * 384 * 16 && B_VT == REC_BYTES, "scan LDS map");
    const int b = bh >> 2, h = bh & 3, r32 = lane & 31, hh = lane >> 5;
    const size_t ubase = ((size_t)b * 128) * 4 + h;
    const int vtid = tid - 384;
    const unsigned char* vsrc = (const unsigned char*)(ACAT + (size_t)(b * SEQ + (vtid >> 2)) * 2048 + h * 256 + dvs * 32 + (vtid & 3) * 8);
    const int vrd = B_VT + (8 * hh + ((lane & 15) >> 2)) * 64 + (16 * ((lane >> 4) & 1) + 4 * (lane & 3)) * 2;
#define SCAN_STAGE(nn, bufi) do { const unsigned char* src_ = REC + (ubase + 4 * (size_t)(nn)) * REC_BYTES; \
        _Pragma("unroll") for (int k_ = 0; k_ < 7; ++k_) __builtin_amdgcn_global_load_lds((const unsigned*)(src_ + (size_t)(k_ * 384 + tid) * 16), (LAS unsigned*)(lds + (bufi) * BUF + (k_ * 384 + wave * 64) * 16), 16, 0, 0); } while (0)
#define SCAN_VSTAGE(nn, bufi) do { const unsigned char* src_ = vsrc + (size_t)(nn) * 64 * 4096; \
        _Pragma("unroll") for (int k_ = 0; k_ < 2; ++k_) __builtin_amdgcn_global_load_lds((const unsigned*)(src_ + (size_t)k_ * 32 * 4096), (LAS unsigned*)(lds + (bufi) * BUF + B_VT + (k_ * 128 + (wave - 6) * 64) * 16), 16, 0, 0); } while (0)
#define SCAN_VFRAG(s_) __builtin_shufflevector(lds_tr(bufc + vrd + (16 * (s_)) * 64), lds_tr(bufc + vrd + (16 * (s_) + 4) * 64), 0, 1, 2, 3, 4, 5, 6, 7)
    f32x16 accS;
#pragma unroll
    for (int e = 0; e < 16; ++e) accS[e] = 0.f;
    const int kq = wave - 2;
    if (wave < 6) { SCAN_STAGE(0, 0); SCAN_STAGE(1, 1); } else { SCAN_VSTAGE(0, 0); SCAN_VSTAGE(1, 1); }
    for (int e = tid; e < ST_BYTES / 16; e += NTHREADS) *(LAS u32x4*)(lds + ST0 + e * 16) = (u32x4){0u, 0u, 0u, 0u};
    if (wave < 6) asm volatile("s_waitcnt vmcnt(7) lgkmcnt(0)" ::: "memory"); else asm volatile("s_waitcnt vmcnt(2) lgkmcnt(0)" ::: "memory");
    __builtin_amdgcn_s_barrier(); asm volatile("" ::: "memory");
    int slot = 0;
    for (int n = 0; n < 128; ++n) {
        const int cur = n & 1, s1 = (slot == 2) ? 0 : slot + 1, s2 = (s1 == 2) ? 0 : s1 + 1;
        LAS unsigned char* bufc = lds + slot * BUF; LAS unsigned char* stc = lds + ST0 + cur * ST_BYTES; LAS unsigned char* stn = lds + ST0 + (cur ^ 1) * ST_BYTES;
        if (wave < 2) {
            const int ra = 32 * wave + r32;
            f32x16 acc;
#pragma unroll
            for (int e = 0; e < 16; ++e) acc[e] = 0.f;
#pragma unroll
            for (int s = 0; s < 4; ++s) { const bf16x8 a = lds_frag(bufc + B_AM + ra * 128 + ((((2 * s + hh) ^ ((ra >> 1) & 7))) << 4)); const bf16x8 bv = SCAN_VFRAG(s);
                acc = __builtin_amdgcn_mfma_f32_32x32x16_bf16(a, bv, acc, 0, 0, 0); }
#pragma unroll
            for (int s = 0; s < 8; ++s) { const bf16x8 a = lds_frag(bufc + B_QI + ra * 256 + ((((2 * s + hh) ^ (ra & 15))) << 4)), bs = lds_frag(stc + r32 * 256 + ((((2 * s + hh) ^ (r32 & 15))) << 4));
                acc = __builtin_amdgcn_mfma_f32_32x32x16_bf16(a, bs, acc, 0, 0, 0); }
            if (n + 2 < 128) SCAN_STAGE(n + 2, s2);
            bf16_t* orow = O + (size_t)(b * SEQ + n * 64 + 32 * wave + 4 * hh) * 2048 + h * 256 + dvs * 32 + r32;
#pragma unroll
            for (int e = 0; e < 16; ++e) orow[(size_t)((e & 3) + 8 * (e >> 2)) * 2048] = f2bf(acc[e]);
        } else if (wave < 6) {
            const int ra = 32 * kq + r32;
#pragma unroll
            for (int g = 0; g < 4; ++g) { const f32x4 dc = *(const LAS f32x4*)(bufc + B_DEC + (32 * kq + 8 * g + 4 * hh) * 4);
#pragma unroll
                for (int e = 0; e < 4; ++e) accS[4 * g + e] *= dc[e]; }
#pragma unroll
            for (int s = 0; s < 4; ++s) { const bf16x8 a = lds_frag(bufc + B_KDT + ra * 128 + ((((2 * s + hh) ^ ((ra >> 1) & 7))) << 4)); const bf16x8 bv = SCAN_VFRAG(s);
                accS = __builtin_amdgcn_mfma_f32_32x32x16_bf16(a, bv, accS, 0, 0, 0); }
#pragma unroll
            for (int g = 0; g < 4; ++g) { u32x2 w; w.x = cvt_pk_c(accS[4 * g], accS[4 * g + 1]); w.y = cvt_pk_c(accS[4 * g + 2], accS[4 * g + 3]);
                *(LAS u32x2*)(stn + r32 * 256 + ((((4 * kq + g) ^ (r32 & 15))) << 4) + 8 * hh) = w; }
            if (n + 2 < 128) SCAN_STAGE(n + 2, s2);
        } else { if (n + 2 < 128) SCAN_VSTAGE(n + 2, s2); }
        if (n + 2 < 128) { if (wave < 2) asm volatile("s_waitcnt vmcnt(23) lgkmcnt(0)" ::: "memory"); else if (wave < 6) asm volatile("s_waitcnt vmcnt(7) lgkmcnt(0)" ::: "memory"); else asm volatile("s_waitcnt vmcnt(2) lgkmcnt(0)" ::: "memory"); }
        else asm volatile("s_waitcnt vmcnt(0) lgkmcnt(0)" ::: "memory");
        __builtin_amdgcn_s_barrier(); asm volatile("" ::: "memory");
        slot = s1;
    }
    asm volatile("s_waitcnt vmcnt(0) lgkmcnt(0)" ::: "memory"); __syncthreads();
#undef SCAN_STAGE
#undef SCAN_VSTAGE
#undef SCAN_VFRAG
}

__device__ __forceinline__ void gla_fin(const Params& P, int lane, int gw, int NGW) {
    const bf16_t* SZA = (const bf16_t*)(P.ws + WS_SZA); bf16_t* ACAT = (bf16_t*)(P.ws + WS_ACAT);
    f32x4 gn[2]; gn[0] = *(const f32x4*)(P.gla_norm_g + ((8 * lane) & 255)); gn[1] = *(const f32x4*)(P.gla_norm_g + ((8 * lane) & 255) + 4);
    for (int t = gw; t < T_TOK; t += NGW) {
        f32x4 o0[2], o1[2], z0[2], z1[2];
#pragma unroll
        for (int j = 0; j < 2; ++j) { const size_t c0 = (size_t)512 * j + 8 * lane; pg8::unpack8(*(const u32x4*)(ACAT + (size_t)t * 2048 + c0), o0[j], o1[j]); pg8::unpack8(*(const u32x4*)(SZA + (size_t)t * 1024 + c0), z0[j], z1[j]); }
#pragma unroll
        for (int j = 0; j < 2; ++j) { const size_t c0 = (size_t)512 * j + 8 * lane;
            float ss = ((o0[j][0] * o0[j][0] + o0[j][1] * o0[j][1]) + (o0[j][2] * o0[j][2] + o0[j][3] * o0[j][3])) + ((o1[j][0] * o1[j][0] + o1[j][1] * o1[j][1]) + (o1[j][2] * o1[j][2] + o1[j][3] * o1[j][3]));
#pragma unroll
            for (int m = 1; m < 32; m <<= 1) ss += __shfl_xor(ss, m);
            const float rstd = 1.0f / sqrtf(ss * (1.f / 256.f) + EPS);
            *(u32x4*)(ACAT + (size_t)t * 2048 + c0) = pg8::pack8(o0[j] * rstd * gn[0] * z0[j], o1[j] * rstd * gn[1] * z1[j]); }
    }
}
__device__ __forceinline__ void conv_rows(const Params& P, int lane, int gw, int NGW) {
    const bf16_t* WCX = (const bf16_t*)(P.ws + WS_WCX); bf16_t* ACAT = (bf16_t*)(P.ws + WS_ACAT);
    f32x4 cw[2][3][2];
#pragma unroll
    for (int j = 0; j < 2; ++j)
#pragma unroll
        for (int k = 0; k < 3; ++k) { cw[j][k][0] = *(const f32x4*)(P.conv_w + k * 1024 + 512 * j + 8 * lane); cw[j][k][1] = *(const f32x4*)(P.conv_w + k * 1024 + 512 * j + 8 * lane + 4); }
    for (int t = gw; t < T_TOK; t += NGW) {
        const int tl = t & (SEQ - 1);
        u32x4 wg[2], wc[2], wb[2], wa[2];
#pragma unroll
        for (int j = 0; j < 2; ++j) { const size_t c0 = (size_t)512 * j + 8 * lane;
            wg[j] = *(const u32x4*)(ACAT + (size_t)t * 2048 + 1024 + c0); wc[j] = *(const u32x4*)(WCX + (size_t)t * 1024 + c0);
            wb[j] = (tl >= 1) ? *(const u32x4*)(WCX + (size_t)(t - 1) * 1024 + c0) : (u32x4){0u, 0u, 0u, 0u}; wa[j] = (tl >= 2) ? *(const u32x4*)(WCX + (size_t)(t - 2) * 1024 + c0) : (u32x4){0u, 0u, 0u, 0u}; }
#pragma unroll
        for (int j = 0; j < 2; ++j) { const size_t c0 = (size_t)512 * j + 8 * lane;
            f32x4 g0, g1, a0, a1, b0, b1, c0v, c1v; pg8::unpack8(wg[j], g0, g1); pg8::unpack8(wc[j], c0v, c1v); pg8::unpack8(wb[j], b0, b1); pg8::unpack8(wa[j], a0, a1);
            const f32x4 u0 = cw[j][0][0] * a0 + cw[j][1][0] * b0 + cw[j][2][0] * c0v, u1 = cw[j][0][1] * a1 + cw[j][1][1] * b1 + cw[j][2][1] * c1v;
            *(u32x4*)(ACAT + (size_t)t * 2048 + 1024 + c0) = pg8::pack8(g0 * u0, g1 * u1); }
    }
}

__device__ __forceinline__ void final_norm(const Params& P, int lane, int gw, int NGW) {
    const float* RS3 = (const float*)(P.ws + WS_GKLOW);
    f32x4 gv[4];
#pragma unroll
    for (int j = 0; j < 4; ++j) gv[j] = *(const f32x4*)(P.norm_final_g + 4 * lane + 256 * j);
    for (int row = gw; row < T_TOK; row += NGW) {
        const f32x4* rs = (const f32x4*)(RS3 + (size_t)row * 16); const f32x4 q0 = rs[0], q1 = rs[1], q2 = rs[2], q3 = rs[3];
        const float ss = ((q0[0] + q0[1]) + (q0[2] + q0[3])) + ((q1[0] + q1[1]) + (q1[2] + q1[3])) + ((q2[0] + q2[1]) + (q2[2] + q2[3])) + ((q3[0] + q3[1]) + (q3[2] + q3[3]));
        const float rstd = 1.0f / sqrtf(ss * (1.f / DM) + EPS);
        float* o = P.out + (size_t)row * DM;
#pragma unroll
        for (int j = 0; j < 4; ++j) { const f32x4 v = *(const f32x4*)(o + 4 * lane + 256 * j); *(f32x4*)(o + 4 * lane + 256 * j) = v * rstd * gv[j]; }
    }
}

#define RLX_AGENT __ATOMIC_RELAXED, __HIP_MEMORY_SCOPE_AGENT
#define XB_TMO      128
#define XB_XCNT(j)  (256  + 64 * (j))
#define XB_XSUB(j)  (1280 + 64 * (j))
#define XB_XGEN(j)  (2304 + 64 * (j))
#define XB_TOP      3328
#define XB_TOPGEN   3392
#define XCD_BAR_WORDS 3456
#define XB_SPIN_CAP (1u << 18)

__device__ __forceinline__ unsigned xb_ld(unsigned* p)              { return __hip_atomic_load(p, __ATOMIC_RELAXED, __HIP_MEMORY_SCOPE_AGENT); }
__device__ __forceinline__ unsigned xb_add(unsigned* p, unsigned v) { return __hip_atomic_fetch_add(p, v, __ATOMIC_RELAXED, __HIP_MEMORY_SCOPE_AGENT); }
__device__ __forceinline__ unsigned xb_xcc_id() { return (unsigned)__builtin_amdgcn_s_getreg((3 << 11) | 20) & 0xFu; }
#define XB_SPIN(cond, bar) do { unsigned _sp = 0; while (cond) { __builtin_amdgcn_s_sleep(1); \
    if ((++_sp & 255u) == 0u) { if (xb_ld(&(bar)[XB_TMO])) break; if (_sp > XB_SPIN_CAP) { atomicAdd(&(bar)[XB_TMO], 1u); break; } } } } while (0)

struct XcdBarrier {
    unsigned* bar; unsigned x;
    volatile LAS unsigned* st;
};

__device__ __forceinline__ XcdBarrier xcd_barrier_post(unsigned* bar, volatile LAS unsigned* st) {
    XcdBarrier b; b.bar = bar; b.x = xb_xcc_id(); b.st = st;
    if (threadIdx.x == 0) (void)xb_add(&bar[XB_XCNT(b.x)], 1u);
    return b;
}
__device__ __forceinline__ void xcd_barrier_complete(unsigned* bar, unsigned x, unsigned& nloc, unsigned& nx) {
    const unsigned G = gridDim.x * gridDim.y * gridDim.z;
    unsigned sum, cnt, mine, sp = 0u;
    for (;;) {
        sum = 0u; cnt = 0u; mine = 0u;
#pragma unroll
        for (unsigned j = 0; j < 16; ++j) { const unsigned c = xb_ld(&bar[XB_XCNT(j)]); sum += c; cnt += (c > 0u) ? 1u : 0u; mine = (j == x) ? c : mine; }
        if (sum == G) break;
        __builtin_amdgcn_s_sleep(1);
        if ((++sp & 255u) == 0u) { if (xb_ld(&bar[XB_TMO])) break; if (sp > XB_SPIN_CAP) { atomicAdd(&bar[XB_TMO], 1u); break; } }
    }
    nloc = mine > 0u ? mine : 1u; nx = cnt > 0u ? cnt : 1u;
}

__device__ __forceinline__ void xcd_barrier(const XcdBarrier& b) {
    asm volatile("s_waitcnt vmcnt(0)" ::: "memory");
    __syncthreads();
    if (threadIdx.x == 0) {
        unsigned* bar = b.bar;
        __builtin_amdgcn_s_waitcnt(0);
        unsigned nloc = b.st[0], nx = b.st[1];
        if (nloc == 0u) { xcd_barrier_complete(bar, b.x, nloc, nx); b.st[0] = nloc; b.st[1] = nx; }
        const unsigned old = xb_add(&bar[XB_XSUB(b.x)], 1u);
        const unsigned gen = old / nloc;
        if (old + 1u == (gen + 1u) * nloc) {
            __builtin_amdgcn_fence(__ATOMIC_RELEASE, "agent");
            asm volatile("s_waitcnt vmcnt(0)" ::: "memory");
            const unsigned og = xb_add(&bar[XB_TOP], 1u);
            const unsigned tg = og / nx;
            if (og + 1u == (tg + 1u) * nx) xb_add(&bar[XB_TOPGEN], 1u);
            else XB_SPIN(xb_ld(&bar[XB_TOPGEN]) == tg, bar);
            __builtin_amdgcn_fence(__ATOMIC_ACQUIRE, "agent");
            xb_add(&bar[XB_XGEN(b.x)], 1u);
            asm volatile("s_waitcnt vmcnt(0)" ::: "memory");
        } else {
            XB_SPIN(xb_ld(&bar[XB_XGEN(b.x)]) == gen, bar);
            __builtin_amdgcn_fence(__ATOMIC_ACQUIRE, "agent");
            asm volatile("s_waitcnt vmcnt(0)" ::: "memory");
        }
    }
    __syncthreads();
}


constexpr int N_PHASES = 9;
#ifndef SKIPMASK
#define SKIPMASK 0
#endif

#ifndef MK_N_LAUNCHES
#define MK_N_LAUNCHES 1
#endif
__global__ void __launch_bounds__(NTHREADS, 2) mk_fwd(Params P) {
    extern __shared__ __attribute__((aligned(16))) unsigned char lds_raw[];
    LAS unsigned char* lds = (LAS unsigned char*)lds_raw;
    const int tid = threadIdx.x, lane = tid & 63, wave = __builtin_amdgcn_readfirstlane(tid >> 6);
    const int G = gridDim.x, bx = blockIdx.x, vcu = (G % 8 == 0) ? (bx % 8) * (G / 8) + bx / 8 : bx;
    const int lo = P.ph_lo, hi = P.ph_hi;
    if (tid < 64) ((LAS unsigned*)(lds + MISC_OFF))[tid] = 0u;
    __syncthreads();
    XcdBarrier bar = xcd_barrier_post((unsigned*)(P.ws + WS_CTL) + 1024, (volatile LAS unsigned*)(lds + MISC_OFF) + 8);
#define IN(k) (lo <= (k) && (k) < hi)
#define SEAM(k) do { if (IN(k) && IN((k) + 1)) xcd_barrier(bar); } while (0)
    bf16_t* WIN_T = (bf16_t*)(P.ws + WS_WIN); bf16_t* WCAT_T = (bf16_t*)(P.ws + WS_WCAT); bf16_t* WOUT_T = (bf16_t*)(P.ws + WS_WOUT); bf16_t* WPG_T = (bf16_t*)(P.ws + WS_WPG); bf16_t* WPE_T = (bf16_t*)(P.ws + WS_WPE);
    bf16_t* H = (bf16_t*)((unsigned char*)P.out + OUT_H); bf16_t* PB = (bf16_t*)((unsigned char*)P.out + OUT_PB);
    bf16_t* QK = (bf16_t*)(P.ws + WS_QK); bf16_t* ACAT = (bf16_t*)(P.ws + WS_ACAT); bf16_t* SZA = (bf16_t*)(P.ws + WS_SZA); bf16_t* WCX = (bf16_t*)(P.ws + WS_WCX);
    bf16_t* RB = QK;
    bf16_t* SGC = (bf16_t*)((unsigned char*)P.out + 40 * MiB); bf16_t* SGC_HI = (bf16_t*)(P.ws + WS_US + 42 * MiB) - (size_t)12288 * 1024;
    bf16_t* MERGED = SZA; bf16_t* PE = WCX; bf16_t* X2B = QK;
    float* ROWSS2 = (float*)(P.ws + WS_ROWSS2); float* ROWSS3 = (float*)(P.ws + WS_GKLOW);

    unsigned long long ts0_ = 0, ts1_ = 0;
#define TS_MARK(k) do { if (PROBE_TS >= 0) { if ((k) == PROBE_TS) ts0_ = __builtin_amdgcn_s_memrealtime(); if ((k) == PROBE_TS + 1) ts1_ = __builtin_amdgcn_s_memrealtime(); } } while (0)
    TS_MARK(0);
    if (IN(0) && !(SKIPMASK & 1)) { p0_prologue(P, lds, tid, lane, wave, vcu, G); }
    SEAM(0);
    TS_MARK(1);
    if (IN(1) && !(SKIPMASK & 2)) {
        pg8::Gemm g{H, WIN_T, T_TOK, 7168, 1024}; pg8::StaticOrder S; S.init(T_TOK, 7168, G, bx); S.rsh = PROBE_REP_G1A;
        pg8::EpiIn E{QK, ACAT, SZA, WCX, RB, SGC, SGC_HI, P.b_merge, -1};
        pg8::gemm_phase<pg8::EpiIn, pg8::StaticOrder, true, true>(lds, g, S, E);
    }
    SEAM(1);
    TS_MARK(2);
    if (IN(2) && !(SKIPMASK & 4)) { gla_prep(P, lds, tid, lane, wave, vcu, G); }
    SEAM(2);
    TS_MARK(3);
    if (IN(3) && !(SKIPMASK & 8)) {
        if (bx < 64) gla_scan(P, lds, tid, lane, wave, bx & 7, bx >> 3);
        else {
            pg8::Gemm g{H, WIN_T, T_TOK, 9216, 1024}; pg8::GateOrder L{G - 64, bx - 64}; pg8::EpiIn E{QK, ACAT, SZA, WCX, RB, SGC, SGC_HI, P.b_merge, -1};
            pg8::gemm_phase<pg8::EpiIn, pg8::GateOrder, true, true>(lds, g, L, E);
            conv_rows(P, lane, (bx - 64) * NWAVES + wave, (G - 64) * NWAVES);
        }
    }
    SEAM(3);
    TS_MARK(4);
    if (IN(4) && !(SKIPMASK & 16)) { gla_fin(P, lane, vcu * NWAVES + wave, G * NWAVES); }
    SEAM(4);
    TS_MARK(5);
    if (IN(5) && !(SKIPMASK & 32)) {
        { pg8::Gemm g{PB, WPE_T, T_TOK, 1024, 256}; pg8::StaticOrder S; S.init(T_TOK, 1024, G, bx); pg8::EpiPlain E{PE, 1024, -1};
          pg8::gemm_phase<pg8::EpiPlain, pg8::StaticOrder, false, true>(lds, g, S, E); }
        { pg8::Gemm g{ACAT, WCAT_T, T_TOK, 1024, 2048}; pg8::StaticOrder S; S.init(T_TOK, 1024, G, bx); S.rsh = PROBE_REP_P5; pg8::EpiMerge E{RB, SGC, SGC_HI, MERGED, 16};
          pg8::gemm_phase<pg8::EpiMerge, pg8::StaticOrder, false, true>(lds, g, S, E); }
    }
    SEAM(5);
    TS_MARK(6);
    if (IN(6) && !(SKIPMASK & 64)) {
        pg8::Gemm g{MERGED, WOUT_T, T_TOK, 1024, 1024}; pg8::StaticOrder S; S.init(T_TOK, 1024, G, bx); S.rsh = PROBE_REP_P6;
        pg8::EpiOut E{P.x, P.out, X2B, ROWSS2, -1};
        pg8::gemm_phase<pg8::EpiOut, pg8::StaticOrder, false, true>(lds, g, S, E);
    }
    SEAM(6);
    TS_MARK(7);
    if (IN(7) && !(SKIPMASK & 128)) {
        pg8::Gemm g{X2B, WPG_T, T_TOK, 1024, 1024}; pg8::StaticOrder S; S.init(T_TOK, 1024, G, bx);
        pg8::EpiPle E{P.out, PE, ROWSS2, ROWSS3, -1};
        pg8::gemm_phase<pg8::EpiPle, pg8::StaticOrder, false, true>(lds, g, S, E);
    }
    SEAM(7);
    TS_MARK(8);
    if (IN(8) && !(SKIPMASK & 256)) { final_norm(P, lane, vcu * NWAVES + wave, G * NWAVES); }
    TS_MARK(9);
    if (PROBE_TS >= 0 && bx == 0) { const unsigned long long until_ = __builtin_amdgcn_s_memrealtime() + 4ull * (ts1_ - ts0_); while (__builtin_amdgcn_s_memrealtime() < until_) __builtin_amdgcn_s_sleep(8); }
#undef IN
#undef SEAM
}

extern "C" void kernel_launch(void* const* d_in, const int* in_sizes, int n_in, void* d_out, int out_size, void* d_ws, size_t ws_size, hipStream_t stream) {
    static int grid = 0;
    if (grid == 0) {
        if (n_in != 16 || in_sizes[0] != T_TOK * DM || out_size != T_TOK * DM || ws_size < WS_END) { fprintf(stderr, "kernel_launch: unexpected shapes (n_in %d, in0 %d, out %d, ws %zu)\n", n_in, n_in > 0 ? in_sizes[0] : -1, out_size, ws_size); grid = -1; return; }
        int dev = 0, cus = 0, per_cu = 0;
        if (hipGetDevice(&dev) != hipSuccess || hipDeviceGetAttribute(&cus, hipDeviceAttributeMultiprocessorCount, dev) != hipSuccess) { grid = -1; return; }
        if (hipFuncSetAttribute((const void*)mk_fwd, hipFuncAttributeMaxDynamicSharedMemorySize, LDS_BYTES) != hipSuccess) { fprintf(stderr, "kernel_launch: hipFuncSetAttribute failed\n"); grid = -1; return; }
        if (hipOccupancyMaxActiveBlocksPerMultiprocessor(&per_cu, (const void*)mk_fwd, NTHREADS, LDS_BYTES) != hipSuccess || per_cu < 1) { fprintf(stderr, "kernel_launch: occupancy query says %d\n", per_cu); per_cu = 1; }
        (void)hipGetLastError();
        grid = cus;
    }
    if (grid < 0) return;
    if (hipMemsetAsync((char*)d_ws + WS_CTL, 0, 65536, stream) != hipSuccess) { fprintf(stderr, "kernel_launch: hipMemsetAsync failed\n"); return; }
    Params p{};
    const float** dst = (const float**)&p;
    for (int i = 0; i < 16; ++i) dst[i] = (const float*)d_in[i];
    p.out = (float*)d_out; p.ws = (unsigned char*)d_ws;
#if MK_N_LAUNCHES == 1
    p.ph_lo = 0; p.ph_hi = N_PHASES;
    void* args[] = {&p};
    hipError_t e = hipLaunchCooperativeKernel((const void*)mk_fwd, dim3(grid), dim3(NTHREADS), args, LDS_BYTES, stream);
    if (e != hipSuccess) fprintf(stderr, "kernel_launch: cooperative launch failed: %s (grid %d)\n", hipGetErrorString(e), grid);
#else
    for (int ph = 0; ph < N_PHASES; ++ph) { p.ph_lo = ph; p.ph_hi = ph + 1; hipLaunchKernelGGL(mk_fwd, dim3(grid), dim3(NTHREADS), LDS_BYTES, stream, p); }
#endif
}
```

```cpp
#include <hip/hip_runtime.h>
#include <cstdio>
#include <cstdint>
#ifndef PROBE_REP_G1A
#define PROBE_REP_G1A 0
#endif
#ifndef PROBE_REP_PREP
#define PROBE_REP_PREP 0
#endif
#ifndef PROBE_REP_P5
#define PROBE_REP_P5 0
#endif
#ifndef PROBE_REP_P6
#define PROBE_REP_P6 0
#endif
#ifndef PROBE_REP_P0
#define PROBE_REP_P0 0
#endif
#ifndef PROBE_TS
#define PROBE_TS -1
#endif
#ifndef PROBE_REP_P8
#define PROBE_REP_P8 0
#endif
namespace pg8 {
#define PG8_LAS __attribute__((address_space(3)))
typedef unsigned short bf16_t;
typedef short bf16x8 __attribute__((ext_vector_type(8)));
typedef float f32x4 __attribute__((ext_vector_type(4)));
typedef unsigned u32x4 __attribute__((ext_vector_type(4)));
constexpr int BM = 256, BK = 64, HALF = 128, HTB = HALF * BK * 2  , STAGE_BYTES = 8 * HTB, NXCD = 8, WGM = 8;

__host__ __device__ __forceinline__ int lds_byte(int r, int c) { const int st = (r >> 4) * 2 + (c >> 5), rr = r & 15, cc = c & 31, ob = rr * 64 + cc * 2; return st * 1024 + (ob ^ (((ob >> 9) & 1) << 5)); }
__host__ __device__ __forceinline__ void stage_rc(int b, int& R, int& C) { const int st = b / 1024, sb = b % 1024, swz = sb ^ (((sb >> 9) & 1) << 5); R = (st >> 1) * 16 + swz / 64; C = (st & 1) * 32 + (swz % 64) / 2; }
__host__ __device__ __forceinline__ int perm32(int rho) { const int n = rho >> 4, i = rho & 15; return 8 * (i >> 2) + 4 * n + (i & 3); }

struct Unit { int pm, pn; };
struct Gemm { const bf16_t* A; const bf16_t* Bt; int M, N, K; };

struct StaticOrder {
    int nM, nN, nwg, G, c; int rsh = 0;
    __host__ __device__ void init(int M, int N, int G_, int c_) { nM = M / BM; nN = N / BM; nwg = nM * nN; G = G_; c = c_; }
    __host__ __device__ bool next(int i, Unit& u) const {
        const long L = (long)(i >> rsh) * G + c; if (L >= nwg) return false;
        int wgid = (int)L; { const int q = nwg / NXCD, r = nwg % NXCD, xcd = wgid % NXCD, off = wgid / NXCD; wgid = (xcd < r ? xcd * (q + 1) : r * (q + 1) + (xcd - r) * q) + off; }
        const int nig = WGM * nN, gid = wgid / nig, fm = gid * WGM, gsz = (nM - fm) < WGM ? (nM - fm) : WGM;
        u.pm = fm + ((wgid % nig) % gsz); u.pn = (wgid % nig) / gsz; return true;
    }
    __device__ __forceinline__ void a_ready(const Unit&) const {}
    __device__ __forceinline__ void done(const Unit&) const {}
};

__device__ __forceinline__ unsigned cvt_pk_bf16(float lo, float hi) { unsigned r; asm volatile("v_cvt_pk_bf16_f32 %0, %1, %2" : "=v"(r) : "v"(lo), "v"(hi)); return r; }
typedef float f32x2 __attribute__((ext_vector_type(2)));
typedef unsigned u32x2 __attribute__((ext_vector_type(2)));
__device__ __forceinline__ float bf_lo(unsigned w) { return __uint_as_float(w << 16); }
__device__ __forceinline__ float bf_hi(unsigned w) { return __uint_as_float(w & 0xffff0000u); }
__device__ __forceinline__ float fsigmoid(float v) { return __builtin_amdgcn_rcpf(1.f + __expf(-v)); }
__device__ __forceinline__ float fsilu(float v) { return v * __builtin_amdgcn_rcpf(1.f + __expf(-v)); }
__device__ __forceinline__ u32x4 pack8(const f32x4 a, const f32x4 b) { u32x4 w; w.x = cvt_pk_bf16(a[0], a[1]); w.y = cvt_pk_bf16(a[2], a[3]); w.z = cvt_pk_bf16(b[0], b[1]); w.w = cvt_pk_bf16(b[2], b[3]); return w; }
__device__ __forceinline__ void unpack8(const u32x4 w, f32x4& a, f32x4& b) { a = (f32x4){bf_lo(w.x), bf_hi(w.x), bf_lo(w.y), bf_hi(w.y)}; b = (f32x4){bf_lo(w.z), bf_hi(w.z), bf_lo(w.w), bf_hi(w.w)}; }
__device__ __forceinline__ f32x4 silu4(f32x4 v) { return (f32x4){fsilu(v[0]), fsilu(v[1]), fsilu(v[2]), fsilu(v[3])}; }
__device__ __forceinline__ f32x4 sigm4(f32x4 v) { return (f32x4){fsigmoid(v[0]), fsigmoid(v[1]), fsigmoid(v[2]), fsigmoid(v[3])}; }

struct EpiIn {
    static constexpr bool PERM = true, AFTER_DRAIN = false, MIDK = false;
    bf16_t *QK, *ACAT, *SZA, *WCX, *R, *SGC, *SGC_HI; const float* b_merge; int mid_t;
    __device__ __forceinline__ void mid(f32x4 (&)[2][2][4][2], const Unit&, int, int, int, int) const {}
    __device__ __forceinline__ void operator()(const f32x4 (&acc)[2][2][4][2], const Unit& u, int wr, int wc, int fr, int fq) const {
        const int pn = u.pn, row0 = u.pm * BM + wr * 64 + fr, c8 = wc * 32 + 8 * fq;
        __builtin_amdgcn_sched_barrier(0); asm volatile("s_nop 15\n\ts_nop 15\n\ts_nop 15\n\ts_nop 15" ::: "memory"); __builtin_amdgcn_sched_barrier(0);
        if (pn < 12) {
            bf16_t* base; int ldc, colt; const bool act = pn >= 8;
            if (pn < 4) { base = QK; ldc = 1024; colt = pn * 256; } else if (pn < 8) { base = ACAT; ldc = 2048; colt = (pn - 4) * 256; } else { base = SZA; ldc = 1024; colt = (pn - 8) * 256; }
#pragma unroll
            for (int ai = 0; ai < 2; ++ai)
#pragma unroll
                for (int m = 0; m < 4; ++m) { bf16_t* rowp = base + (size_t)(row0 + ai * HALF + m * 16) * ldc + colt + c8;
#pragma unroll
                    for (int bj = 0; bj < 2; ++bj) { f32x4 v0 = acc[ai][bj][m][0], v1 = acc[ai][bj][m][1]; if (act) { v0 = silu4(v0); v1 = silu4(v1); }
                        *(u32x4*)(rowp + bj * HALF) = pack8(v0, v1); } }
        } else if (pn < 28) {
            const bool isw = pn < 20; const int j = isw ? pn - 12 : pn - 20; bf16_t* base = isw ? WCX : ACAT + 1024; const int ldc = isw ? 1024 : 2048;
#pragma unroll
            for (int ai = 0; ai < 2; ++ai)
#pragma unroll
                for (int m = 0; m < 4; ++m) { bf16_t* rowp = base + (size_t)(row0 + ai * HALF + m * 16) * ldc + j * HALF + c8;
                    f32x4 b0 = acc[ai][1][m][0], b1 = acc[ai][1][m][1]; if (!isw) { b0 = silu4(b0); b1 = silu4(b1); }
                    *(u32x4*)rowp = pack8(acc[ai][0][m][0] * b0, acc[ai][0][m][1] * b1); }
        } else {
            const int j = pn - 28, ch = j * HALF + c8;
            const f32x4 ba0 = *(const f32x4*)(b_merge + ch), ba1 = *(const f32x4*)(b_merge + ch + 4), bc0 = *(const f32x4*)(b_merge + 1024 + ch), bc1 = *(const f32x4*)(b_merge + 1024 + ch + 4);
#pragma unroll
            for (int ai = 0; ai < 2; ++ai)
#pragma unroll
                for (int m = 0; m < 4; ++m) { const size_t off = (size_t)(row0 + ai * HALF + m * 16) * 1024 + ch;
                    const f32x4 sa0 = sigm4(acc[ai][0][m][0] + ba0), sa1 = sigm4(acc[ai][0][m][1] + ba1), sc0 = sigm4(acc[ai][1][m][0] + bc0), sc1 = sigm4(acc[ai][1][m][1] + bc1);
                    f32x4 r0, r1;
#pragma unroll
                    for (int e = 0; e < 4; ++e) { r0[e] = sa0[e] * __builtin_amdgcn_rcpf(sc0[e]); r1[e] = sa1[e] * __builtin_amdgcn_rcpf(sc1[e]); }
                    *(u32x4*)(R + off) = pack8(r0, r1); *(u32x4*)((u.pm < 48 ? SGC : SGC_HI) + off) = pack8(sc0, sc1); }
        }
    }
};
struct EpiPlain {
    static constexpr bool PERM = true, AFTER_DRAIN = false, MIDK = false;
    bf16_t* O; int ldc; int mid_t;
    __device__ __forceinline__ void mid(f32x4 (&)[2][2][4][2], const Unit&, int, int, int, int) const {}
    __device__ __forceinline__ void operator()(const f32x4 (&acc)[2][2][4][2], const Unit& u, int wr, int wc, int fr, int fq) const {
        const int row0 = u.pm * BM + wr * 64 + fr, col0 = u.pn * BM + wc * 32 + 8 * fq;
        __builtin_amdgcn_sched_barrier(0); asm volatile("s_nop 15\n\ts_nop 15\n\ts_nop 15\n\ts_nop 15" ::: "memory"); __builtin_amdgcn_sched_barrier(0);
#pragma unroll
        for (int ai = 0; ai < 2; ++ai)
#pragma unroll
            for (int m = 0; m < 4; ++m) { bf16_t* rowp = O + (size_t)(row0 + ai * HALF + m * 16) * ldc + col0;
#pragma unroll
                for (int bj = 0; bj < 2; ++bj) *(u32x4*)(rowp + bj * HALF) = pack8(acc[ai][bj][m][0], acc[ai][bj][m][1]); }
    }
};
struct EpiMerge {
    static constexpr bool PERM = true, AFTER_DRAIN = false, MIDK = true;
    const bf16_t *R, *SGC, *SGC_HI; bf16_t* O; int mid_t;
    __device__ __forceinline__ void mid(f32x4 (&acc)[2][2][4][2], const Unit& u, int wr, int wc, int fr, int fq) const {
        int row0 = u.pm * BM + wr * 64 + fr, col0 = u.pn * BM + wc * 32 + 8 * fq; asm volatile("" : "+v"(row0), "+v"(col0));
#pragma unroll
        for (int ai = 0; ai < 2; ++ai)
#pragma unroll
            for (int m = 0; m < 4; ++m) { const bf16_t* rowp = R + (size_t)(row0 + ai * HALF + m * 16) * 1024 + col0;
#pragma unroll
                for (int bj = 0; bj < 2; ++bj) { f32x4 r0, r1; unpack8(*(const u32x4*)(rowp + bj * HALF), r0, r1); acc[ai][bj][m][0] *= r0; acc[ai][bj][m][1] *= r1; }
                if (m & 1) asm volatile("" ::: "memory"); }
    }
    __device__ __forceinline__ void operator()(const f32x4 (&acc)[2][2][4][2], const Unit& u, int wr, int wc, int fr, int fq) const {
        const int row0 = u.pm * BM + wr * 64 + fr, col0 = u.pn * BM + wc * 32 + 8 * fq;
#pragma unroll
        for (int ai = 0; ai < 2; ++ai)
#pragma unroll
            for (int m = 0; m < 4; ++m) { const size_t off = (size_t)(row0 + ai * HALF + m * 16) * 1024 + col0;
#pragma unroll
                for (int bj = 0; bj < 2; ++bj) { f32x4 s0, s1; unpack8(*(const u32x4*)((u.pm < 48 ? SGC : SGC_HI) + off + bj * HALF), s0, s1);
                    *(u32x4*)(O + off + bj * HALF) = pack8(acc[ai][bj][m][0] * s0, acc[ai][bj][m][1] * s1); }
                if (m & 1) asm volatile("" ::: "memory"); }
    }
};
struct EpiOut {
    static constexpr bool PERM = false, AFTER_DRAIN = false, MIDK = false;
    const float* x; float* x2; bf16_t* x2b; float* rowss; int mid_t;
    __device__ __forceinline__ void mid(f32x4 (&)[2][2][4][2], const Unit&, int, int, int, int) const {}
    __device__ __forceinline__ void operator()(const f32x4 (&acc)[2][2][4][2], const Unit& u, int wr, int wc, int fr, int fq) const {
        const int col0 = u.pn * BM + wc * 32 + 4 * fq;
#pragma unroll
        for (int ai = 0; ai < 2; ++ai)
#pragma unroll
            for (int m = 0; m < 4; ++m) { const int row = u.pm * BM + ai * HALF + wr * 64 + m * 16 + fr; const size_t off = (size_t)row * 1024 + col0; float s = 0.f;
#pragma unroll
                for (int bj = 0; bj < 2; ++bj)
#pragma unroll
                    for (int n = 0; n < 2; ++n) { const size_t c = off + bj * HALF + n * 16; const f32x4 o = *(const f32x4*)(x + c) + acc[ai][bj][m][n];
                        *(f32x4*)(x2 + c) = o; u32x2 w; w.x = cvt_pk_bf16(o[0], o[1]); w.y = cvt_pk_bf16(o[2], o[3]); *(u32x2*)(x2b + c) = w;
                        s += (o[0] * o[0] + o[1] * o[1]) + (o[2] * o[2] + o[3] * o[3]); }
                s += __shfl_xor(s, 16); s += __shfl_xor(s, 32);
                if (fq == 0) rowss[(size_t)row * 16 + u.pn * 4 + wc] = s;
                asm volatile("" ::: "memory"); }
    }
};
struct EpiPle {
    static constexpr bool PERM = false, AFTER_DRAIN = false, MIDK = false;
    float* xio; const bf16_t* pe; const float* rowss2; float* rowss3; int mid_t;
    __device__ __forceinline__ void mid(f32x4 (&)[2][2][4][2], const Unit&, int, int, int, int) const {}
    __device__ __forceinline__ void operator()(const f32x4 (&acc)[2][2][4][2], const Unit& u, int wr, int wc, int fr, int fq) const {
        const int col0 = u.pn * BM + wc * 32 + 4 * fq;
#pragma unroll
        for (int ai = 0; ai < 2; ++ai)
#pragma unroll
            for (int m = 0; m < 4; ++m) { const int row = u.pm * BM + ai * HALF + wr * 64 + m * 16 + fr; const size_t off = (size_t)row * 1024 + col0;
                const f32x4* rs = (const f32x4*)(rowss2 + (size_t)row * 16); const f32x4 q0 = rs[0], q1 = rs[1], q2 = rs[2], q3 = rs[3];
                const float ss = ((q0[0] + q0[1]) + (q0[2] + q0[3])) + ((q1[0] + q1[1]) + (q1[2] + q1[3])) + ((q2[0] + q2[1]) + (q2[2] + q2[3])) + ((q3[0] + q3[1]) + (q3[2] + q3[3]));
                const float rstd = __builtin_amdgcn_rsqf(ss * (1.f / 1024.f) + 1e-6f); float s = 0.f;
#pragma unroll
                for (int bj = 0; bj < 2; ++bj)
#pragma unroll
                    for (int n = 0; n < 2; ++n) { const size_t c = off + bj * HALF + n * 16; const f32x4 g = sigm4(acc[ai][bj][m][n] * rstd); const u32x2 pw = *(const u32x2*)(pe + c);
                        const f32x4 pv = (f32x4){bf_lo(pw.x), bf_hi(pw.x), bf_lo(pw.y), bf_hi(pw.y)}; const f32x4 o = *(const f32x4*)(xio + c) + g * pv;
                        *(f32x4*)(xio + c) = o; s += (o[0] * o[0] + o[1] * o[1]) + (o[2] * o[2] + o[3] * o[3]); }
                s += __shfl_xor(s, 16); s += __shfl_xor(s, 32);
                if (fq == 0) rowss3[(size_t)row * 16 + u.pn * 4 + wc] = s;
                asm volatile("" ::: "memory"); }
    }
};
struct PairOrder { StaticOrder S;
    __device__ __forceinline__ bool next(int i, Unit& u) const { Unit m; if (!S.next(i >> 1, m)) return false; u.pm = m.pm; u.pn = 28 + 2 * m.pn + (i & 1); return true; }
    __device__ __forceinline__ void a_ready(const Unit&) const {}
    __device__ __forceinline__ void done(const Unit&) const {}
};
struct GateOrder { int Gs, c;
    __device__ __forceinline__ bool next(int i, Unit& u) const { const int L = i * Gs + c; if (L >= 512) return false; u.pm = L >> 3; u.pn = 28 + (L & 7); return true; }
    __device__ __forceinline__ void a_ready(const Unit&) const {}
    __device__ __forceinline__ void done(const Unit&) const {}
};
struct ListOrder {
    int pm, pn0, cnt;
    __device__ __forceinline__ bool next(int i, Unit& u) const { if (i >= cnt) return false; u.pm = pm; u.pn = pn0 + i; return true; }
    __device__ __forceinline__ void a_ready(const Unit&) const {}
    __device__ __forceinline__ void done(const Unit&) const {}
};
template <class Epi, class Sched, bool ALIGN_EPI = false, bool SP2 = false>
__device__ __forceinline__ void gemm_phase(PG8_LAS unsigned char* lds, const Gemm g, const Sched& S, const Epi& E) {
    const int tid = threadIdx.x, wid = __builtin_amdgcn_readfirstlane(tid >> 6), lane = tid & 63, wr = wid >> 2, wc = wid & 3, fr = lane & 15, fq = lane >> 4;
    const int K = g.K, nt = K / BK;
    unsigned voffA[2], voffB[2];
#pragma unroll
    for (int i = 0; i < 2; ++i) { int R, C; stage_rc(tid * 16 + i * 8192, R, C); const int Rb = Epi::PERM ? ((R & ~31) + perm32(R & 31)) : R;
        voffA[i] = (unsigned)(R * K + C) * 2u; voffB[i] = (unsigned)(Rb * K + C) * 2u; }
    const size_t kstep = (size_t)(BK * 2);
    const size_t hstep = (size_t)HALF * K * 2;
    const size_t tstep = 2 * hstep;
    const unsigned ldsw = (unsigned)wid * 1024u;
    const int aoff = lds_byte(wr * 64 + fr, fq * 8), boff = lds_byte(wc * 32 + fr, fq * 8);
#define PG8_SA(b, h) (((b) * 2 + (h)) * HTB)
#define PG8_SB(b, h) ((4 + (b) * 2 + (h)) * HTB)
#define PG8_STAGE(bufoff, gbase, voff) do { _Pragma("unroll") for (int _i = 0; _i < 2; ++_i) \
        __builtin_amdgcn_global_load_lds((const unsigned*)((const char*)(gbase) + (voff)[_i]), (PG8_LAS unsigned*)(lds + (bufoff) + ldsw + _i * 8192), 16, 0, 0); } while (0)
#define PG8_LDA(dst, b, h) do { _Pragma("unroll") for (int m = 0; m < 4; ++m) _Pragma("unroll") for (int k = 0; k < 2; ++k) dst[m][k] = *(const PG8_LAS bf16x8*)(lds + PG8_SA(b, h) + aoff + m * 2048 + k * 1024); } while (0)
#define PG8_LDB(dst, b, h) do { _Pragma("unroll") for (int n = 0; n < 2; ++n) _Pragma("unroll") for (int k = 0; k < 2; ++k) dst[n][k] = *(const PG8_LAS bf16x8*)(lds + PG8_SB(b, h) + boff + n * 2048 + k * 1024); } while (0)
#define PG8_MMA(ai, bj, At, Bt) do { __builtin_amdgcn_s_setprio(1); _Pragma("unroll") for (int m = 0; m < 4; ++m) _Pragma("unroll") for (int n = 0; n < 2; ++n) _Pragma("unroll") for (int k = 0; k < 2; ++k) \
        acc[ai][bj][m][n] = __builtin_amdgcn_mfma_f32_16x16x32_bf16(Bt[n][k], At[m][k], acc[ai][bj][m][n], 0, 0, 0); __builtin_amdgcn_s_setprio(0); } while (0)
#define PG8_WAIT_V(n) asm volatile("s_waitcnt vmcnt(" #n ")" ::: "memory")
#define PG8_WAIT_L(n) asm volatile("s_waitcnt lgkmcnt(" #n ")" ::: "memory")
#define PG8_BAR __builtin_amdgcn_s_barrier()
#define PG8_SCHED __builtin_amdgcn_sched_barrier(0)
    Unit cur, nxt; int ui = 0;
    if (!S.next(0, cur)) return;
    f32x4 acc[2][2][4][2];
#pragma unroll
    for (int a = 0; a < 2; ++a)
#pragma unroll
        for (int b = 0; b < 2; ++b)
#pragma unroll
            for (int m = 0; m < 4; ++m)
#pragma unroll
                for (int n = 0; n < 2; ++n) acc[a][b][m][n] = (f32x4){0.f, 0.f, 0.f, 0.f};
    bf16x8 At[4][2], B0[2][2], B1[2][2];
    const char* cA = (const char*)g.A + (size_t)cur.pm * tstep; const char* cB = (const char*)g.Bt + (size_t)cur.pn * tstep;
    S.a_ready(cur);
    if constexpr (SP2) {
        PG8_STAGE(PG8_SB(0, 0), cB, voffB); PG8_STAGE(PG8_SB(0, 1), cB + hstep, voffB); PG8_STAGE(PG8_SA(0, 0), cA, voffA); PG8_STAGE(PG8_SA(0, 1), cA + hstep, voffA);
        if (wr == 1) PG8_BAR;
        PG8_WAIT_V(2); PG8_BAR;
        PG8_STAGE(PG8_SB(1, 0), cB + kstep, voffB); PG8_STAGE(PG8_SA(1, 0), cA + kstep, voffA); PG8_STAGE(PG8_SB(1, 1), cB + hstep + kstep, voffB);
        PG8_WAIT_V(6); PG8_BAR;
    } else {
        PG8_STAGE(PG8_SB(0, 0), cB, voffB); PG8_STAGE(PG8_SA(0, 0), cA, voffA); PG8_STAGE(PG8_SB(0, 1), cB + hstep, voffB); PG8_STAGE(PG8_SA(0, 1), cA + hstep, voffA);
        if (wr == 1) PG8_BAR;
        PG8_WAIT_V(4); PG8_BAR;
        PG8_STAGE(PG8_SB(1, 0), cB + kstep, voffB); PG8_STAGE(PG8_SA(1, 0), cA + kstep, voffA); PG8_STAGE(PG8_SB(1, 1), cB + hstep + kstep, voffB);
        PG8_WAIT_V(6); PG8_BAR;
    }
    for (;;) {
        const bool has_next = S.next(ui + 1, nxt);
        const char* nA = has_next ? (const char*)g.A + (size_t)nxt.pm * tstep : cA; const char* nB = has_next ? (const char*)g.Bt + (size_t)nxt.pn * tstep : cB;
        for (int t = 0; t < nt; t += 2) {
            if constexpr (Epi::MIDK) { if (t == E.mid_t) E.mid(acc, cur, wr, wc, fr, fq); }
            const bool last = (t == nt - 2);
            const char* a1 = cA + (size_t)(t + 1) * kstep;
            const char* a2 = last ? nA : cA + (size_t)(t + 2) * kstep; const char* b2 = last ? nB : cB + (size_t)(t + 2) * kstep;
            const char* a3 = a2 + kstep; const char* b3 = b2 + kstep;
            if (last && has_next) S.a_ready(nxt);
            if constexpr (SP2) {
            PG8_LDB(B0, 0, 0); PG8_LDB(B1, 0, 1); PG8_SCHED; PG8_LDA(At, 0, 0); PG8_STAGE(PG8_SA(1, 1), a1 + hstep, voffA);
            PG8_WAIT_V(8); PG8_WAIT_L(0); PG8_BAR; PG8_MMA(0, 0, At, B0); PG8_MMA(0, 1, At, B1); PG8_BAR; PG8_SCHED;
            PG8_LDA(At, 0, 1); PG8_STAGE(PG8_SB(0, 0), b2, voffB); PG8_STAGE(PG8_SB(0, 1), b2 + hstep, voffB); PG8_STAGE(PG8_SA(0, 0), a2, voffA);
            PG8_WAIT_V(8); PG8_WAIT_L(0); PG8_BAR; PG8_MMA(1, 0, At, B0); PG8_MMA(1, 1, At, B1); PG8_BAR; PG8_SCHED;
            PG8_LDB(B0, 1, 0); PG8_LDB(B1, 1, 1); PG8_SCHED; PG8_LDA(At, 1, 0); PG8_STAGE(PG8_SA(0, 1), a2 + hstep, voffA);
            PG8_WAIT_V(8); PG8_WAIT_L(0); PG8_BAR; PG8_MMA(0, 0, At, B0); PG8_MMA(0, 1, At, B1); PG8_BAR; PG8_SCHED;
            PG8_LDA(At, 1, 1); PG8_STAGE(PG8_SB(1, 0), b3, voffB); PG8_STAGE(PG8_SB(1, 1), b3 + hstep, voffB); PG8_STAGE(PG8_SA(1, 0), a3, voffA);
            PG8_WAIT_V(8); PG8_WAIT_L(0); PG8_BAR; PG8_MMA(1, 0, At, B0); PG8_MMA(1, 1, At, B1); PG8_BAR; PG8_SCHED;
            } else {
            PG8_LDB(B0, 0, 0); PG8_SCHED; PG8_LDA(At, 0, 0); PG8_STAGE(PG8_SA(1, 1), a1 + hstep, voffA);
            PG8_WAIT_L(8); PG8_BAR; PG8_WAIT_L(0); PG8_MMA(0, 0, At, B0); PG8_BAR; PG8_SCHED;
            PG8_LDB(B1, 0, 1); PG8_STAGE(PG8_SB(0, 0), b2, voffB);
            PG8_BAR; PG8_WAIT_L(0); PG8_MMA(0, 1, At, B1); PG8_BAR;
            PG8_LDA(At, 0, 1); PG8_STAGE(PG8_SA(0, 0), a2, voffA);
            PG8_BAR; PG8_WAIT_L(0); PG8_MMA(1, 0, At, B0); PG8_BAR; PG8_SCHED;
            PG8_STAGE(PG8_SB(0, 1), b2 + hstep, voffB);
            PG8_WAIT_V(6); PG8_BAR; PG8_MMA(1, 1, At, B1); PG8_BAR;
            PG8_LDB(B0, 1, 0); PG8_SCHED; PG8_LDA(At, 1, 0); PG8_STAGE(PG8_SA(0, 1), a2 + hstep, voffA);
            PG8_WAIT_L(8); PG8_BAR; PG8_WAIT_L(0); PG8_MMA(0, 0, At, B0); PG8_BAR; PG8_SCHED;
            PG8_LDB(B1, 1, 1); PG8_STAGE(PG8_SB(1, 0), b3, voffB);
            PG8_BAR; PG8_WAIT_L(0); PG8_MMA(0, 1, At, B1); PG8_BAR;
            PG8_LDA(At, 1, 1); PG8_STAGE(PG8_SA(1, 0), a3, voffA);
            PG8_BAR; PG8_WAIT_L(0); PG8_MMA(1, 0, At, B0); PG8_BAR; PG8_SCHED;
            PG8_STAGE(PG8_SB(1, 1), b3 + hstep, voffB);
            PG8_WAIT_V(6); PG8_BAR; PG8_MMA(1, 1, At, B1); PG8_BAR;
            }
        }
        if constexpr (ALIGN_EPI) { if (wr == 0) PG8_BAR; }
        if constexpr (!Epi::AFTER_DRAIN) { E(acc, cur, wr, wc, fr, fq); S.done(cur); }
        if (!has_next) break;
#pragma unroll
        for (int a = 0; a < 2; ++a)
#pragma unroll
            for (int b = 0; b < 2; ++b)
#pragma unroll
                for (int m = 0; m < 4; ++m)
#pragma unroll
                    for (int n = 0; n < 2; ++n) acc[a][b][m][n] = (f32x4){0.f, 0.f, 0.f, 0.f};
        cur = nxt; cA = nA; cB = nB; ++ui;
        if constexpr (ALIGN_EPI) { if (wr == 1) PG8_BAR; }
    }
    PG8_WAIT_V(0);
    if constexpr (!ALIGN_EPI) { if (wr == 0) PG8_BAR; }
    PG8_BAR;
    if constexpr (Epi::AFTER_DRAIN) { E.fused(acc, cur, wr, wc, fr, fq, lds, wid, lane); S.done(cur); }
#undef PG8_SA
#undef PG8_SB
#undef PG8_STAGE
#undef PG8_LDA
#undef PG8_LDB
#undef PG8_MMA
#undef PG8_WAIT_V
#undef PG8_WAIT_L
#undef PG8_BAR
#undef PG8_SCHED
}
}

constexpr int T_TOK = 16384, SEQ = 8192, DM = 1024, IN_COLS = 9232, NCHUNK = SEQ / 64;
constexpr float EPS = 1e-6f;
constexpr int NWAVES = 8, NTHREADS = 512;
constexpr size_t MiB = 1u << 20;
constexpr size_t WS_CTL = 0, CTL_ZERO_BYTES = 1 * MiB;
constexpr size_t WS_WIN = 1 * MiB;
constexpr size_t WS_GKLOW = 19 * MiB;
constexpr size_t WS_DECAY = 20 * MiB;
constexpr size_t WS_ROWSS2 = 21 * MiB;
constexpr size_t WS_QK = 22 * MiB;
constexpr size_t WS_ACAT = 54 * MiB;
constexpr size_t WS_SZA = 118 * MiB;
constexpr size_t WS_WCX = 150 * MiB;
constexpr size_t WS_US = 182 * MiB;
constexpr size_t WS_WCAT = 246 * MiB;
constexpr size_t WS_WOUT = 250 * MiB;
constexpr size_t WS_WPG = 252 * MiB;
constexpr size_t WS_WPE = 254 * MiB;
constexpr size_t WS_END = 256 * MiB;
constexpr size_t OUT_H = 0, OUT_PB = 32 * MiB, OUT_AMAT = 40 * MiB;
constexpr int RING_BYTES = 131072, LDS_BYTES = 163840, MISC_OFF = LDS_BYTES - 256;

#define LAS __attribute__((address_space(3)))
typedef unsigned short bf16_t;
typedef float f32x4 __attribute__((ext_vector_type(4)));
typedef unsigned u32x4 __attribute__((ext_vector_type(4)));
typedef unsigned u32x2 __attribute__((ext_vector_type(2)));
using pg8::cvt_pk_bf16; using pg8::bf_lo; using pg8::bf_hi;
#define LDS_WAIT() asm volatile("s_waitcnt lgkmcnt(0)" ::: "memory")
__device__ __forceinline__ float bf2f(bf16_t v) { return __uint_as_float((unsigned)v << 16); }
__device__ __forceinline__ float wave_sum(float v) {
#pragma unroll
    for (int o = 1; o < 64; o <<= 1) v += __shfl_xor(v, o);
    return v;
}

struct Params {
    const float *x, *p, *norm_mix_g, *w_in, *b_merge, *w_gk2, *b_gk, *gla_norm_g, *conv_w, *w_a, *w_c, *w_out, *norm_ple_g, *w_pg, *w_pe, *norm_final_g;
    float* out; unsigned char* ws; int ph_lo, ph_hi;
};

__device__ __forceinline__ void transpose_item(const float* __restrict__ src, int srcN, int col0, int k0, bf16_t* __restrict__ dst, int dstK, int drow0, int dk0, const float* __restrict__ kscale, LAS float* scr, int lane) {
    const int kr = lane >> 3, c4 = (lane & 7) * 4;
    f32x4 v[8];
#pragma unroll
    for (int i = 0; i < 8; ++i) v[i] = *(const f32x4*)(src + (size_t)(k0 + 8 * i + kr) * srcN + col0 + c4);
#pragma unroll
    for (int i = 0; i < 8; ++i) { const int kk = 8 * i + kr; f32x4 w = v[i]; if (kscale) w = w * kscale[k0 + kk];
        LAS float* s = scr + kk * 33 + c4; s[0] = w[0]; s[1] = w[1]; s[2] = w[2]; s[3] = w[3]; }
    LDS_WAIT(); asm volatile("" ::: "memory");
    const int c = lane & 7;
#pragma unroll
    for (int j = 0; j < 4; ++j) { const int n = (lane >> 3) + 8 * j; const LAS float* s = scr + (8 * c) * 33 + n;
        u32x4 o; o.x = cvt_pk_bf16(s[0 * 33], s[1 * 33]); o.y = cvt_pk_bf16(s[2 * 33], s[3 * 33]); o.z = cvt_pk_bf16(s[4 * 33], s[5 * 33]); o.w = cvt_pk_bf16(s[6 * 33], s[7 * 33]);
        *(u32x4*)(dst + (size_t)(drow0 + n) * dstK + dk0 + k0 + 8 * c) = o; }
    LDS_WAIT(); asm volatile("" ::: "memory");
}
__device__ __forceinline__ int win_colmap(int np) {
    const int tile = np >> 8, r = np & 255;
    if (tile < 12) return np;
    if (tile < 20) { const int j = tile - 12; return r < 128 ? 4112 + 128 * j + r : 5136 + 128 * j + (r - 128); }
    if (tile < 28) { const int j = tile - 20; return r < 128 ? 3088 + 128 * j + r : 6160 + 128 * j + (r - 128); }
    const int j = tile - 28; return r < 128 ? 7184 + 128 * j + r : 8208 + 128 * j + (r - 128);
}
__device__ __forceinline__ void late_weights(const Params& P, LAS unsigned char* lds, int lane, int wave, int gw, int NGW) {
    bf16_t* WCAT_T = (bf16_t*)(P.ws + WS_WCAT); bf16_t* WOUT_T = (bf16_t*)(P.ws + WS_WOUT); bf16_t* WPG_T = (bf16_t*)(P.ws + WS_WPG); bf16_t* WPE_T = (bf16_t*)(P.ws + WS_WPE);
    LAS float* scr = (LAS float*)(lds + wave * 16384);
    constexpr int I_SQ = 16 * 32, I_PE = 4 * 32, NITEMS = 4 * I_SQ + I_PE;
    for (int r = gw; r < NITEMS; r += NGW) {
        const int kb = r / 32 % 16, nb = r % 32, which = r / I_SQ;
        if (which == 0) transpose_item(P.w_a, 1024, 32 * nb, 64 * kb, WCAT_T, 2048, 32 * nb, 0, nullptr, scr, lane);
        else if (which == 1) transpose_item(P.w_c, 1024, 32 * nb, 64 * kb, WCAT_T, 2048, 32 * nb, 1024, nullptr, scr, lane);
        else if (which == 2) transpose_item(P.w_out, 1024, 32 * nb, 64 * kb, WOUT_T, 1024, 32 * nb, 0, nullptr, scr, lane);
        else if (which == 3) transpose_item(P.w_pg, 1024, 32 * nb, 64 * kb, WPG_T, 1024, 32 * nb, 0, P.norm_ple_g, scr, lane);
        else { const int r2 = r - 4 * I_SQ; transpose_item(P.w_pe, 1024, 32 * (r2 % 32), 64 * (r2 / 32), WPE_T, 256, 32 * (r2 % 32), 0, nullptr, scr, lane); }
    }
}
__device__ __forceinline__ void p0_prologue(const Params& P, LAS unsigned char* lds, int tid, int lane, int wave, int vcu, int G) {
    bf16_t* WIN_T = (bf16_t*)(P.ws + WS_WIN);
    bf16_t* H = (bf16_t*)((unsigned char*)P.out + OUT_H); bf16_t* PB = (bf16_t*)((unsigned char*)P.out + OUT_PB); float* GKLOW = (float*)(P.ws + WS_GKLOW);
    LAS float* scr = (LAS float*)(lds + wave * 16384);
    const int gw = vcu * NWAVES + wave, NGW = G * NWAVES;
    constexpr int NITEMS = 16 * 288;
    for (int it = gw; it < (NITEMS << PROBE_REP_P0); it += NGW) {
        const int r = it >= NITEMS ? it - NITEMS : it; const int kb = r / 288, nb = r % 288;
        transpose_item(P.w_in, IN_COLS, win_colmap(32 * nb), 64 * kb, WIN_T, 1024, 32 * nb, 0, nullptr, scr, lane);
    }
    { const float* __restrict__ pp = P.p; bf16_t* __restrict__ pb = PB;
#pragma unroll 4
      for (int ee = vcu * NTHREADS + tid; ee < ((T_TOK * 256 / 8) << PROBE_REP_P0); ee += G * NTHREADS) { const int e = ee & (T_TOK * 256 / 8 - 1); const f32x4 a = *(const f32x4*)(pp + (size_t)e * 8), b = *(const f32x4*)(pp + (size_t)e * 8 + 4);
        *(u32x4*)(pb + (size_t)e * 8) = pg8::pack8(a, b); } }
    __syncthreads();
    LAS float* WgT = (LAS float*)lds;
#pragma unroll
    for (int i = 0; i < 8; ++i) { const int e = tid + NTHREADS * i, k = e >> 2, c4 = (e & 3) * 4; const f32x4 w = *(const f32x4*)(P.w_in + (size_t)k * IN_COLS + 3072 + c4);
        WgT[(c4 + 0) * 1024 + k] = w[0]; WgT[(c4 + 1) * 1024 + k] = w[1]; WgT[(c4 + 2) * 1024 + k] = w[2]; WgT[(c4 + 3) * 1024 + k] = w[3]; }
    __syncthreads();
    f32x4 gv[4];
#pragma unroll
    for (int j = 0; j < 4; ++j) gv[j] = *(const f32x4*)(P.norm_mix_g + 4 * lane + 256 * j);
    f32x4 xn[2][4];
    constexpr int NPAIR = (T_TOK / 2) << PROBE_REP_P0;
    if (gw < NPAIR) {
#pragma unroll
        for (int r = 0; r < 2; ++r)
#pragma unroll
            for (int j = 0; j < 4; ++j) xn[r][j] = *(const f32x4*)(P.x + (size_t)(2 * (gw & (T_TOK / 2 - 1)) + r) * DM + 4 * lane + 256 * j);
    }
    for (int prr = gw; prr < NPAIR; prr += NGW) { const int pr = prr & (T_TOK / 2 - 1);
        f32x4 hv[2][4];
#pragma unroll
        for (int r = 0; r < 2; ++r)
#pragma unroll
            for (int j = 0; j < 4; ++j) hv[r][j] = xn[r][j];
        if (prr + NGW < NPAIR) { const int pn = (prr + NGW) & (T_TOK / 2 - 1);
#pragma unroll
            for (int r = 0; r < 2; ++r)
#pragma unroll
                for (int j = 0; j < 4; ++j) xn[r][j] = *(const f32x4*)(P.x + (size_t)(2 * pn + r) * DM + 4 * lane + 256 * j); }
#pragma unroll
        for (int r = 0; r < 2; ++r) { float ss = 0.f;
#pragma unroll
            for (int j = 0; j < 4; ++j) ss += (hv[r][j][0] * hv[r][j][0] + hv[r][j][1] * hv[r][j][1]) + (hv[r][j][2] * hv[r][j][2] + hv[r][j][3] * hv[r][j][3]);
            const float rstd = 1.0f / sqrtf(wave_sum(ss) * (1.f / DM) + EPS);
            bf16_t* hr = H + (size_t)(2 * pr + r) * DM;
#pragma unroll
            for (int j = 0; j < 4; ++j) { hv[r][j] = hv[r][j] * rstd * gv[j]; u32x2 w; w.x = cvt_pk_bf16(hv[r][j][0], hv[r][j][1]); w.y = cvt_pk_bf16(hv[r][j][2], hv[r][j][3]); *(u32x2*)(hr + 4 * lane + 256 * j) = w; } }
        float g0 = 0.f, g1 = 0.f;
#pragma unroll 1
        for (int c = 0; c < 16; ++c) { float s0 = 0.f, s1 = 0.f;
#pragma unroll
            for (int j = 0; j < 4; ++j) { const f32x4 w = *(const LAS f32x4*)(WgT + c * 1024 + 4 * lane + 256 * j);
                s0 += (hv[0][j][0] * w[0] + hv[0][j][1] * w[1]) + (hv[0][j][2] * w[2] + hv[0][j][3] * w[3]); s1 += (hv[1][j][0] * w[0] + hv[1][j][1] * w[1]) + (hv[1][j][2] * w[2] + hv[1][j][3] * w[3]); }
            s0 = wave_sum(s0); s1 = wave_sum(s1); if (lane == c) { g0 = s0; g1 = s1; } }
        if (lane < 16) { GKLOW[(size_t)(2 * pr) * 16 + lane] = g0; GKLOW[(size_t)(2 * pr + 1) * 16 + lane] = g1; }
    }
}

typedef short bf16x8 __attribute__((ext_vector_type(8)));
typedef float f32x16 __attribute__((ext_vector_type(16)));
constexpr int REC_BYTES = 43008, REC_QI = 0, REC_KDT = 16384, REC_AM = 32768, REC_DEC = 40960;
__device__ __forceinline__ int img256(int row, int col) { return row * 256 + ((((col >> 3) ^ (row & 15))) << 4) + (col & 7) * 2; }
__device__ __forceinline__ int img128(int row, int col) { return row * 128 + ((((col >> 3) ^ ((row >> 1) & 7))) << 4) + (col & 7) * 2; }
typedef float f32x2c __attribute__((ext_vector_type(2))); typedef __bf16 bf16x2c __attribute__((ext_vector_type(2)));
__device__ __forceinline__ unsigned cvt_pk_c(float lo, float hi) { const f32x2c v = {lo, hi}; const bf16x2c b = __builtin_convertvector(v, bf16x2c); return __builtin_bit_cast(unsigned, b); }
__device__ __forceinline__ bf16_t f2bf(float v) { return (bf16_t)(cvt_pk_c(v, 0.f) & 0xffffu); }
__device__ __forceinline__ bf16x8 lds_frag(LAS unsigned char* p) { return *(LAS bf16x8*)p; }

__device__ __forceinline__ void gla_prep(const Params& P, LAS unsigned char* lds, int tid, int lane, int wave, int vcu, int G) {
    const bf16_t* QK = (const bf16_t*)(P.ws + WS_QK); const float* GKLOW = (const float*)(P.ws + WS_GKLOW); unsigned char* REC = P.ws + WS_US;
    LAS float* gl = (LAS float*)lds; LAS float* tot = (LAS float*)(lds + 4096); LAS unsigned char* Qi = lds + 8192; LAS unsigned char* Ki = lds + 24576; LAS unsigned char* Am = lds + 40960;
    const int d = tid & 127, tg = tid >> 7, r32 = lane & 31, hh = lane >> 5;
    for (int uu = vcu; uu < (1024 << PROBE_REP_PREP); uu += G) { const int u = uu & 1023;
        const int h = u & 3, n = (u >> 2) & 127, b = u >> 9, t0 = b * SEQ + n * 64;
        unsigned char* rec = REC + (size_t)u * REC_BYTES;
        for (int e = tid; e < 1024; e += NTHREADS) gl[e] = GKLOW[(size_t)t0 * 16 + e];
        float qv[16], kv[16], w2[16];
#pragma unroll
        for (int i = 0; i < 16; ++i) { const size_t t = (size_t)(t0 + 16 * tg + i); qv[i] = bf2f(QK[t * 1024 + h * 128 + d]); kv[i] = bf2f(QK[t * 1024 + 512 + h * 128 + d]); }
#pragma unroll
        for (int r = 0; r < 16; ++r) w2[r] = P.w_gk2[r * 512 + h * 128 + d];
        const float bias = P.b_gk[h * 128 + d];
        __syncthreads();
        float c[16]; float run = 0.f;
#pragma unroll
        for (int i = 0; i < 16; ++i) { float z = bias;
#pragma unroll
            for (int r4 = 0; r4 < 4; ++r4) { const f32x4 g4 = *(const LAS f32x4*)(gl + (16 * tg + i) * 16 + 4 * r4); z += (g4[0] * w2[4 * r4] + g4[1] * w2[4 * r4 + 1]) + (g4[2] * w2[4 * r4 + 2] + g4[3] * w2[4 * r4 + 3]); }
            const float gk = (fminf(z, 0.f) - __logf(1.f + __expf(-fabsf(z)))) * (1.f / 16.f); run += gk; c[i] = run; }
        tot[tg * 128 + d] = run;
        __syncthreads();
        float off = 0.f, total = 0.f;
#pragma unroll
        for (int g = 0; g < 4; ++g) { const float v = tot[g * 128 + d]; total += v; if (g < tg) off += v; }
        float kd[16];
#pragma unroll
        for (int i = 0; i < 16; ++i) { const float bb = off + c[i]; const int t = 16 * tg + i;
            *(LAS bf16_t*)(Qi + img256(t, d)) = f2bf(qv[i] * 0.08838834764831845f * __expf(bb));
            *(LAS bf16_t*)(Ki + img256(t, d)) = f2bf(kv[i] * __expf(-bb));
            kd[i] = kv[i] * __expf(total - bb); }
        {
            u32x4 w0, w1; w0.x = cvt_pk_bf16(kd[0], kd[1]); w0.y = cvt_pk_bf16(kd[2], kd[3]); w0.z = cvt_pk_bf16(kd[4], kd[5]); w0.w = cvt_pk_bf16(kd[6], kd[7]);
            w1.x = cvt_pk_bf16(kd[8], kd[9]); w1.y = cvt_pk_bf16(kd[10], kd[11]); w1.z = cvt_pk_bf16(kd[12], kd[13]); w1.w = cvt_pk_bf16(kd[14], kd[15]);
            *(u32x4*)(rec + REC_KDT + img128(d, 16 * tg)) = w0; *(u32x4*)(rec + REC_KDT + img128(d, 16 * tg + 8)) = w1; }
        if (tg == 0) ((float*)(rec + REC_DEC))[d] = __expf(total);
        __syncthreads();
        if (wave < 4) {
            const int mi = wave >> 1, nj = wave & 1, ra = 32 * mi + r32, rb = 32 * nj + r32;
            f32x16 acc;
#pragma unroll
            for (int e = 0; e < 16; ++e) acc[e] = 0.f;
#pragma unroll
            for (int s = 0; s < 8; ++s) { const bf16x8 a = lds_frag(Qi + ra * 256 + ((((2 * s + hh) ^ (ra & 15))) << 4)), bq = lds_frag(Ki + rb * 256 + ((((2 * s + hh) ^ (rb & 15))) << 4));
                acc = __builtin_amdgcn_mfma_f32_32x32x16_bf16(a, bq, acc, 0, 0, 0); }
            const int j = 32 * nj + r32;
#pragma unroll
            for (int e = 0; e < 16; ++e) { const int i = 32 * mi + (e & 3) + 8 * (e >> 2) + 4 * hh; *(LAS bf16_t*)(Am + img128(i, j)) = f2bf(j <= i ? acc[e] : 0.f); }
        }
#pragma unroll
        for (int k = 0; k < 2; ++k) { const int ch = tid + NTHREADS * k; *(u32x4*)(rec + REC_QI + ch * 16) = *(LAS u32x4*)(Qi + ch * 16); }
        __syncthreads();
        *(u32x4*)(rec + REC_AM + tid * 16) = *(LAS u32x4*)(Am + tid * 16);
        __syncthreads();
    }
}

typedef short s16x4 __attribute__((ext_vector_type(4)));
__device__ __forceinline__ s16x4 lds_tr(LAS unsigned char* p) { return __builtin_bit_cast(s16x4, __builtin_amdgcn_ds_read_tr16_b64_v4i16((LAS s16x4*)p)); }
__device__ __forceinline__ void gla_scan(const Params& P, LAS unsigned char* lds, int tid, int lane, int wave, int bh, int dvs) {
    const unsigned char* REC = P.ws + WS_US; bf16_t* ACAT = (bf16_t*)(P.ws + WS_ACAT); bf16_t* O = ACAT;
    constexpr int BUF = 47104, B_QI = 0, B_KDT = 16384, B_AM = 32768, B_DEC = 40960, B_VT = 43008, ST0 = 3 * BUF, ST_BYTES = 8192;
    static_assert(ST0 + 2 * ST_BYTES <= MISC_OFF && REC_BYTES == 7 * 384 * 16 && B_VT == REC_BYTES, "scan LDS map");
    const int b = bh >> 2, h = bh & 3, r32 = lane & 31, hh = lane >> 5;
    const size_t ubase = ((size_t)b * 128) * 4 + h;
    const int vtid = tid - 384;
    const unsigned char* vsrc = (const unsigned char*)(ACAT + (size_t)(b * SEQ + (vtid >> 2)) * 2048 + h * 256 + dvs * 32 + (vtid & 3) * 8);
    const int vrd = B_VT + (8 * hh + ((lane & 15) >> 2)) * 64 + (16 * ((lane >> 4) & 1) + 4 * (lane & 3)) * 2;
#define SCAN_STAGE(nn, bufi) do { const unsigned char* src_ = REC + (ubase + 4 * (size_t)(nn)) * REC_BYTES; \
        _Pragma("unroll") for (int k_ = 0; k_ < 7; ++k_) __builtin_amdgcn_global_load_lds((const unsigned*)(src_ + (size_t)(k_ * 384 + tid) * 16), (LAS unsigned*)(lds + (bufi) * BUF + (k_ * 384 + wave * 64) * 16), 16, 0, 0); } while (0)
#define SCAN_VSTAGE(nn, bufi) do { const unsigned char* src_ = vsrc + (size_t)(nn) * 64 * 4096; \
        _Pragma("unroll") for (int k_ = 0; k_ < 2; ++k_) __builtin_amdgcn_global_load_lds((const unsigned*)(src_ + (size_t)k_ * 32 * 4096), (LAS unsigned*)(lds + (bufi) * BUF + B_VT + (k_ * 128 + (wave - 6) * 64) * 16), 16, 0, 0); } while (0)
#define SCAN_VFRAG(s_) __builtin_shufflevector(lds_tr(bufc + vrd + (16 * (s_)) * 64), lds_tr(bufc + vrd + (16 * (s_) + 4) * 64), 0, 1, 2, 3, 4, 5, 6, 7)
    f32x16 accS;
#pragma unroll
    for (int e = 0; e < 16; ++e) accS[e] = 0.f;
    const int kq = wave - 2;
    if (wave < 6) { SCAN_STAGE(0, 0); SCAN_STAGE(1, 1); } else { SCAN_VSTAGE(0, 0); SCAN_VSTAGE(1, 1); }
    for (int e = tid; e < ST_BYTES / 16; e += NTHREADS) *(LAS u32x4*)(lds + ST0 + e * 16) = (u32x4){0u, 0u, 0u, 0u};
    if (wave < 6) asm volatile("s_waitcnt vmcnt(7) lgkmcnt(0)" ::: "memory"); else asm volatile("s_waitcnt vmcnt(2) lgkmcnt(0)" ::: "memory");
    __builtin_amdgcn_s_barrier(); asm volatile("" ::: "memory");
    int slot = 0;
    for (int n = 0; n < 128; ++n) {
        const int cur = n & 1, s1 = (slot == 2) ? 0 : slot + 1, s2 = (s1 == 2) ? 0 : s1 + 1;
        LAS unsigned char* bufc = lds + slot * BUF; LAS unsigned char* stc = lds + ST0 + cur * ST_BYTES; LAS unsigned char* stn = lds + ST0 + (cur ^ 1) * ST_BYTES;
        if (wave < 2) {
            const int ra = 32 * wave + r32;
            f32x16 acc;
#pragma unroll
            for (int e = 0; e < 16; ++e) acc[e] = 0.f;
#pragma unroll
            for (int s = 0; s < 4; ++s) { const bf16x8 a = lds_frag(bufc + B_AM + ra * 128 + ((((2 * s + hh) ^ ((ra >> 1) & 7))) << 4)); const bf16x8 bv = SCAN_VFRAG(s);
                acc = __builtin_amdgcn_mfma_f32_32x32x16_bf16(a, bv, acc, 0, 0, 0); }
#pragma unroll
            for (int s = 0; s < 8; ++s) { const bf16x8 a = lds_frag(bufc + B_QI + ra * 256 + ((((2 * s + hh) ^ (ra & 15))) << 4)), bs = lds_frag(stc + r32 * 256 + ((((2 * s + hh) ^ (r32 & 15))) << 4));
                acc = __builtin_amdgcn_mfma_f32_32x32x16_bf16(a, bs, acc, 0, 0, 0); }
            if (n + 2 < 128) SCAN_STAGE(n + 2, s2);
            bf16_t* orow = O + (size_t)(b * SEQ + n * 64 + 32 * wave + 4 * hh) * 2048 + h * 256 + dvs * 32 + r32;
#pragma unroll
            for (int e = 0; e < 16; ++e) orow[(size_t)((e & 3) + 8 * (e >> 2)) * 2048] = f2bf(acc[e]);
        } else if (wave < 6) {
            const int ra = 32 * kq + r32;
#pragma unroll
            for (int g = 0; g < 4; ++g) { const f32x4 dc = *(const LAS f32x4*)(bufc + B_DEC + (32 * kq + 8 * g + 4 * hh) * 4);
#pragma unroll
                for (int e = 0; e < 4; ++e) accS[4 * g + e] *= dc[e]; }
#pragma unroll
            for (int s = 0; s < 4; ++s) { const bf16x8 a = lds_frag(bufc + B_KDT + ra * 128 + ((((2 * s + hh) ^ ((ra >> 1) & 7))) << 4)); const bf16x8 bv = SCAN_VFRAG(s);
                accS = __builtin_amdgcn_mfma_f32_32x32x16_bf16(a, bv, accS, 0, 0, 0); }
#pragma unroll
            for (int g = 0; g < 4; ++g) { u32x2 w; w.x = cvt_pk_c(accS[4 * g], accS[4 * g + 1]); w.y = cvt_pk_c(accS[4 * g + 2], accS[4 * g + 3]);
                *(LAS u32x2*)(stn + r32 * 256 + ((((4 * kq + g) ^ (r32 & 15))) << 4) + 8 * hh) = w; }
            if (n + 2 < 128) SCAN_STAGE(n + 2, s2);
        } else { if (n + 2 < 128) SCAN_VSTAGE(n + 2, s2); }
        if (n + 2 < 128) { if (wave < 2) asm volatile("s_waitcnt vmcnt(23) lgkmcnt(0)" ::: "memory"); else if (wave < 6) asm volatile("s_waitcnt vmcnt(7) lgkmcnt(0)" ::: "memory"); else asm volatile("s_waitcnt vmcnt(2) lgkmcnt(0)" ::: "memory"); }
        else asm volatile("s_waitcnt vmcnt(0) lgkmcnt(0)" ::: "memory");
        __builtin_amdgcn_s_barrier(); asm volatile("" ::: "memory");
        slot = s1;
    }
    asm volatile("s_waitcnt vmcnt(0) lgkmcnt(0)" ::: "memory"); __syncthreads();
#undef SCAN_STAGE
#undef SCAN_VSTAGE
#undef SCAN_VFRAG
}

__device__ __forceinline__ void gla_fin(const Params& P, int lane, int gw, int NGW) {
    const bf16_t* SZA = (const bf16_t*)(P.ws + WS_SZA); bf16_t* ACAT = (bf16_t*)(P.ws + WS_ACAT);
    f32x4 gn[2]; gn[0] = *(const f32x4*)(P.gla_norm_g + ((8 * lane) & 255)); gn[1] = *(const f32x4*)(P.gla_norm_g + ((8 * lane) & 255) + 4);
    for (int t = gw; t < T_TOK; t += NGW) {
        f32x4 o0[2], o1[2], z0[2], z1[2];
#pragma unroll
        for (int j = 0; j < 2; ++j) { const size_t c0 = (size_t)512 * j + 8 * lane; pg8::unpack8(*(const u32x4*)(ACAT + (size_t)t * 2048 + c0), o0[j], o1[j]); pg8::unpack8(*(const u32x4*)(SZA + (size_t)t * 1024 + c0), z0[j], z1[j]); }
#pragma unroll
        for (int j = 0; j < 2; ++j) { const size_t c0 = (size_t)512 * j + 8 * lane;
            float ss = ((o0[j][0] * o0[j][0] + o0[j][1] * o0[j][1]) + (o0[j][2] * o0[j][2] + o0[j][3] * o0[j][3])) + ((o1[j][0] * o1[j][0] + o1[j][1] * o1[j][1]) + (o1[j][2] * o1[j][2] + o1[j][3] * o1[j][3]));
#pragma unroll
            for (int m = 1; m < 32; m <<= 1) ss += __shfl_xor(ss, m);
            const float rstd = 1.0f / sqrtf(ss * (1.f / 256.f) + EPS);
            *(u32x4*)(ACAT + (size_t)t * 2048 + c0) = pg8::pack8(o0[j] * rstd * gn[0] * z0[j], o1[j] * rstd * gn[1] * z1[j]); }
    }
}
__device__ __forceinline__ void conv_rows(const Params& P, int lane, int gw, int NGW) {
    const bf16_t* WCX = (const bf16_t*)(P.ws + WS_WCX); bf16_t* ACAT = (bf16_t*)(P.ws + WS_ACAT);
    f32x4 cw[2][3][2];
#pragma unroll
    for (int j = 0; j < 2; ++j)
#pragma unroll
        for (int k = 0; k < 3; ++k) { cw[j][k][0] = *(const f32x4*)(P.conv_w + k * 1024 + 512 * j + 8 * lane); cw[j][k][1] = *(const f32x4*)(P.conv_w + k * 1024 + 512 * j + 8 * lane + 4); }
    for (int t = gw; t < T_TOK; t += NGW) {
        const int tl = t & (SEQ - 1);
        u32x4 wg[2], wc[2], wb[2], wa[2];
#pragma unroll
        for (int j = 0; j < 2; ++j) { const size_t c0 = (size_t)512 * j + 8 * lane;
            wg[j] = *(const u32x4*)(ACAT + (size_t)t * 2048 + 1024 + c0); wc[j] = *(const u32x4*)(WCX + (size_t)t * 1024 + c0);
            wb[j] = (tl >= 1) ? *(const u32x4*)(WCX + (size_t)(t - 1) * 1024 + c0) : (u32x4){0u, 0u, 0u, 0u}; wa[j] = (tl >= 2) ? *(const u32x4*)(WCX + (size_t)(t - 2) * 1024 + c0) : (u32x4){0u, 0u, 0u, 0u}; }
#pragma unroll
        for (int j = 0; j < 2; ++j) { const size_t c0 = (size_t)512 * j + 8 * lane;
            f32x4 g0, g1, a0, a1, b0, b1, c0v, c1v; pg8::unpack8(wg[j], g0, g1); pg8::unpack8(wc[j], c0v, c1v); pg8::unpack8(wb[j], b0, b1); pg8::unpack8(wa[j], a0, a1);
            const f32x4 u0 = cw[j][0][0] * a0 + cw[j][1][0] * b0 + cw[j][2][0] * c0v, u1 = cw[j][0][1] * a1 + cw[j][1][1] * b1 + cw[j][2][1] * c1v;
            *(u32x4*)(ACAT + (size_t)t * 2048 + 1024 + c0) = pg8::pack8(g0 * u0, g1 * u1); }
    }
}

__device__ __forceinline__ void final_norm(const Params& P, int lane, int gw, int NGW) {
    const float* RS3 = (const float*)(P.ws + WS_GKLOW);
    f32x4 gv[4];
#pragma unroll
    for (int j = 0; j < 4; ++j) gv[j] = *(const f32x4*)(P.norm_final_g + 4 * lane + 256 * j);
    for (int row = gw; row < T_TOK; row += NGW) {
        const f32x4* rs = (const f32x4*)(RS3 + (size_t)row * 16); const f32x4 q0 = rs[0], q1 = rs[1], q2 = rs[2], q3 = rs[3];
        const float ss = ((q0[0] + q0[1]) + (q0[2] + q0[3])) + ((q1[0] + q1[1]) + (q1[2] + q1[3])) + ((q2[0] + q2[1]) + (q2[2] + q2[3])) + ((q3[0] + q3[1]) + (q3[2] + q3[3]));
        const float rstd = 1.0f / sqrtf(ss * (1.f / DM) + EPS);
        float* o = P.out + (size_t)row * DM;
#pragma unroll
        for (int j = 0; j < 4; ++j) { const f32x4 v = *(const f32x4*)(o + 4 * lane + 256 * j); *(f32x4*)(o + 4 * lane + 256 * j) = v * rstd * gv[j]; }
    }
}

#define RLX_AGENT __ATOMIC_RELAXED, __HIP_MEMORY_SCOPE_AGENT
#define XB_TMO      128
#define XB_XCNT(j)  (256  + 64 * (j))
#define XB_XSUB(j)  (1280 + 64 * (j))
#define XB_XGEN(j)  (2304 + 64 * (j))
#define XB_TOP      3328
#define XB_TOPGEN   3392
#define XCD_BAR_WORDS 3456
#define XB_SPIN_CAP (1u << 18)

__device__ __forceinline__ unsigned xb_ld(unsigned* p)              { return __hip_atomic_load(p, __ATOMIC_RELAXED, __HIP_MEMORY_SCOPE_AGENT); }
__device__ __forceinline__ unsigned xb_add(unsigned* p, unsigned v) { return __hip_atomic_fetch_add(p, v, __ATOMIC_RELAXED, __HIP_MEMORY_SCOPE_AGENT); }
__device__ __forceinline__ unsigned xb_xcc_id() { return (unsigned)__builtin_amdgcn_s_getreg((3 << 11) | 20) & 0xFu; }
#define XB_SPIN(cond, bar) do { unsigned _sp = 0; while (cond) { __builtin_amdgcn_s_sleep(1); \
    if ((++_sp & 255u) == 0u) { if (xb_ld(&(bar)[XB_TMO])) break; if (_sp > XB_SPIN_CAP) { atomicAdd(&(bar)[XB_TMO], 1u); break; } } } } while (0)

struct XcdBarrier {
    unsigned* bar; unsigned x;
    volatile LAS unsigned* st;
};

__device__ __forceinline__ XcdBarrier xcd_barrier_post(unsigned* bar, volatile LAS unsigned* st) {
    XcdBarrier b; b.bar = bar; b.x = xb_xcc_id(); b.st = st;
    if (threadIdx.x == 0) (void)xb_add(&bar[XB_XCNT(b.x)], 1u);
    return b;
}
__device__ __forceinline__ void xcd_barrier_complete(unsigned* bar, unsigned x, unsigned& nloc, unsigned& nx) {
    const unsigned G = gridDim.x * gridDim.y * gridDim.z;
    unsigned sum, cnt, mine, sp = 0u;
    for (;;) {
        sum = 0u; cnt = 0u; mine = 0u;
#pragma unroll
        for (unsigned j = 0; j < 16; ++j) { const unsigned c = xb_ld(&bar[XB_XCNT(j)]); sum += c; cnt += (c > 0u) ? 1u : 0u; mine = (j == x) ? c : mine; }
        if (sum == G) break;
        __builtin_amdgcn_s_sleep(1);
        if ((++sp & 255u) == 0u) { if (xb_ld(&bar[XB_TMO])) break; if (sp > XB_SPIN_CAP) { atomicAdd(&bar[XB_TMO], 1u); break; } }
    }
    nloc = mine > 0u ? mine : 1u; nx = cnt > 0u ? cnt : 1u;
}

__device__ __forceinline__ void xcd_barrier(const XcdBarrier& b) {
    asm volatile("s_waitcnt vmcnt(0)" ::: "memory");
    __syncthreads();
    if (threadIdx.x == 0) {
        unsigned* bar = b.bar;
        __builtin_amdgcn_s_waitcnt(0);
        unsigned nloc = b.st[0], nx = b.st[1];
        if (nloc == 0u) { xcd_barrier_complete(bar, b.x, nloc, nx); b.st[0] = nloc; b.st[1] = nx; }
        const unsigned old = xb_add(&bar[XB_XSUB(b.x)], 1u);
        const unsigned gen = old / nloc;
        if (old + 1u == (gen + 1u) * nloc) {
            __builtin_amdgcn_fence(__ATOMIC_RELEASE, "agent");
            asm volatile("s_waitcnt vmcnt(0)" ::: "memory");
            const unsigned og = xb_add(&bar[XB_TOP], 1u);
            const unsigned tg = og / nx;
            if (og + 1u == (tg + 1u) * nx) xb_add(&bar[XB_TOPGEN], 1u);
            else XB_SPIN(xb_ld(&bar[XB_TOPGEN]) == tg, bar);
            __builtin_amdgcn_fence(__ATOMIC_ACQUIRE, "agent");
            xb_add(&bar[XB_XGEN(b.x)], 1u);
            asm volatile("s_waitcnt vmcnt(0)" ::: "memory");
        } else {
            XB_SPIN(xb_ld(&bar[XB_XGEN(b.x)]) == gen, bar);
            __builtin_amdgcn_fence(__ATOMIC_ACQUIRE, "agent");
            asm volatile("s_waitcnt vmcnt(0)" ::: "memory");
        }
    }
    __syncthreads();
}


constexpr int N_PHASES = 9;
#ifndef SKIPMASK
#define SKIPMASK 0
#endif

#ifndef MK_N_LAUNCHES
#define MK_N_LAUNCHES 1
#endif
__global__ void __launch_bounds__(NTHREADS, 2) mk_fwd(Params P) {
    extern __shared__ __attribute__((aligned(16))) unsigned char lds_raw[];
    LAS unsigned char* lds = (LAS unsigned char*)lds_raw;
    const int tid = threadIdx.x, lane = tid & 63, wave = __builtin_amdgcn_readfirstlane(tid >> 6);
    const int G = gridDim.x, bx = blockIdx.x, vcu = (G % 8 == 0) ? (bx % 8) * (G / 8) + bx / 8 : bx;
    const int lo = P.ph_lo, hi = P.ph_hi;
    if (tid < 64) ((LAS unsigned*)(lds + MISC_OFF))[tid] = 0u;
    __syncthreads();
    XcdBarrier bar = xcd_barrier_post((unsigned*)(P.ws + WS_CTL) + 1024, (volatile LAS unsigned*)(lds + MISC_OFF) + 8);
#define IN(k) (lo <= (k) && (k) < hi)
#define SEAM(k) do { if (IN(k) && IN((k) + 1)) xcd_barrier(bar); } while (0)
    bf16_t* WIN_T = (bf16_t*)(P.ws + WS_WIN); bf16_t* WCAT_T = (bf16_t*)(P.ws + WS_WCAT); bf16_t* WOUT_T = (bf16_t*)(P.ws + WS_WOUT); bf16_t* WPG_T = (bf16_t*)(P.ws + WS_WPG); bf16_t* WPE_T = (bf16_t*)(P.ws + WS_WPE);
    bf16_t* H = (bf16_t*)((unsigned char*)P.out + OUT_H); bf16_t* PB = (bf16_t*)((unsigned char*)P.out + OUT_PB);
    bf16_t* QK = (bf16_t*)(P.ws + WS_QK); bf16_t* ACAT = (bf16_t*)(P.ws + WS_ACAT); bf16_t* SZA = (bf16_t*)(P.ws + WS_SZA); bf16_t* WCX = (bf16_t*)(P.ws + WS_WCX);
    bf16_t* RB = QK;
    bf16_t* SGC = (bf16_t*)((unsigned char*)P.out + 40 * MiB); bf16_t* SGC_HI = (bf16_t*)(P.ws + WS_US + 42 * MiB) - (size_t)12288 * 1024;
    bf16_t* MERGED = SZA; bf16_t* PE = WCX; bf16_t* X2B = QK;
    float* ROWSS2 = (float*)(P.ws + WS_ROWSS2); float* ROWSS3 = (float*)(P.ws + WS_GKLOW);

    unsigned long long ts0_ = 0, ts1_ = 0;
#define TS_MARK(k) do { if (PROBE_TS >= 0) { if ((k) == PROBE_TS) ts0_ = __builtin_amdgcn_s_memrealtime(); if ((k) == PROBE_TS + 1) ts1_ = __builtin_amdgcn_s_memrealtime(); } } while (0)
    TS_MARK(0);
    if (IN(0) && !(SKIPMASK & 1)) { p0_prologue(P, lds, tid, lane, wave, vcu, G); }
    SEAM(0);
    TS_MARK(1);
    if (IN(1) && !(SKIPMASK & 2)) {
        pg8::Gemm g{H, WIN_T, T_TOK, 7168, 1024}; pg8::StaticOrder S; S.init(T_TOK, 7168, G, bx); S.rsh = PROBE_REP_G1A;
        pg8::EpiIn E{QK, ACAT, SZA, WCX, RB, SGC, SGC_HI, P.b_merge, -1};
        pg8::gemm_phase<pg8::EpiIn, pg8::StaticOrder, true, true>(lds, g, S, E);
    }
    SEAM(1);
    TS_MARK(2);
    if (IN(2) && !(SKIPMASK & 4)) { gla_prep(P, lds, tid, lane, wave, vcu, G); }
    SEAM(2);
    TS_MARK(3);
    if (IN(3) && !(SKIPMASK & 8)) {
        if (bx < 64) gla_scan(P, lds, tid, lane, wave, bx & 7, bx >> 3);
        else {
            pg8::Gemm g{H, WIN_T, T_TOK, 9216, 1024}; pg8::GateOrder L{G - 64, bx - 64}; pg8::EpiIn E{QK, ACAT, SZA, WCX, RB, SGC, SGC_HI, P.b_merge, -1};
            pg8::gemm_phase<pg8::EpiIn, pg8::GateOrder, true, true>(lds, g, L, E);
            conv_rows(P, lane, (bx - 64) * NWAVES + wave, (G - 64) * NWAVES);
            late_weights(P, lds, lane, wave, (bx - 64) * NWAVES + wave, (G - 64) * NWAVES);
        }
    }
    SEAM(3);
    TS_MARK(4);
    if (IN(4) && !(SKIPMASK & 16)) { gla_fin(P, lane, vcu * NWAVES + wave, G * NWAVES); }
    SEAM(4);
    TS_MARK(5);
    if (IN(5) && !(SKIPMASK & 32)) {
        { pg8::Gemm g{PB, WPE_T, T_TOK, 1024, 256}; pg8::StaticOrder S; S.init(T_TOK, 1024, G, bx); pg8::EpiPlain E{PE, 1024, -1};
          pg8::gemm_phase<pg8::EpiPlain, pg8::StaticOrder, false, true>(lds, g, S, E); }
        { pg8::Gemm g{ACAT, WCAT_T, T_TOK, 1024, 2048}; pg8::StaticOrder S; S.init(T_TOK, 1024, G, bx); S.rsh = PROBE_REP_P5; pg8::EpiMerge E{RB, SGC, SGC_HI, MERGED, 16};
          pg8::gemm_phase<pg8::EpiMerge, pg8::StaticOrder, false, true>(lds, g, S, E); }
    }
    SEAM(5);
    TS_MARK(6);
    if (IN(6) && !(SKIPMASK & 64)) {
        pg8::Gemm g{MERGED, WOUT_T, T_TOK, 1024, 1024}; pg8::StaticOrder S; S.init(T_TOK, 1024, G, bx); S.rsh = PROBE_REP_P6;
        pg8::EpiOut E{P.x, P.out, X2B, ROWSS2, -1};
        pg8::gemm_phase<pg8::EpiOut, pg8::StaticOrder, false, true>(lds, g, S, E);
    }
    SEAM(6);
    TS_MARK(7);
    if (IN(7) && !(SKIPMASK & 128)) {
        pg8::Gemm g{X2B, WPG_T, T_TOK, 1024, 1024}; pg8::StaticOrder S; S.init(T_TOK, 1024, G, bx);
        pg8::EpiPle E{P.out, PE, ROWSS2, ROWSS3, -1};
        pg8::gemm_phase<pg8::EpiPle, pg8::StaticOrder, false, true>(lds, g, S, E);
    }
    SEAM(7);
    TS_MARK(8);
    if (IN(8) && !(SKIPMASK & 256)) { final_norm(P, lane, vcu * NWAVES + wave, G * NWAVES); }
    TS_MARK(9);
    if (PROBE_TS >= 0 && bx == 0) { const unsigned long long until_ = __builtin_amdgcn_s_memrealtime() + 4ull * (ts1_ - ts0_); while (__builtin_amdgcn_s_memrealtime() < until_) __builtin_amdgcn_s_sleep(8); }
#undef IN
#undef SEAM
}

extern "C" void kernel_launch(void* const* d_in, const int* in_sizes, int n_in, void* d_out, int out_size, void* d_ws, size_t ws_size, hipStream_t stream) {
    static int grid = 0;
    if (grid == 0) {
        if (n_in != 16 || in_sizes[0] != T_TOK * DM || out_size != T_TOK * DM || ws_size < WS_END) { fprintf(stderr, "kernel_launch: unexpected shapes (n_in %d, in0 %d, out %d, ws %zu)\n", n_in, n_in > 0 ? in_sizes[0] : -1, out_size, ws_size); grid = -1; return; }
        int dev = 0, cus = 0, per_cu = 0;
        if (hipGetDevice(&dev) != hipSuccess || hipDeviceGetAttribute(&cus, hipDeviceAttributeMultiprocessorCount, dev) != hipSuccess) { grid = -1; return; }
        if (hipFuncSetAttribute((const void*)mk_fwd, hipFuncAttributeMaxDynamicSharedMemorySize, LDS_BYTES) != hipSuccess) { fprintf(stderr, "kernel_launch: hipFuncSetAttribute failed\n"); grid = -1; return; }
        if (hipOccupancyMaxActiveBlocksPerMultiprocessor(&per_cu, (const void*)mk_fwd, NTHREADS, LDS_BYTES) != hipSuccess || per_cu < 1) { fprintf(stderr, "kernel_launch: occupancy query says %d\n", per_cu); per_cu = 1; }
        (void)hipGetLastError();
        grid = cus;
    }
    if (grid < 0) return;
    if (hipMemsetAsync((char*)d_ws + WS_CTL, 0, 65536, stream) != hipSuccess) { fprintf(stderr, "kernel_launch: hipMemsetAsync failed\n"); return; }
    Params p{};
    const float** dst = (const float**)&p;
    for (int i = 0; i < 16; ++i) dst[i] = (const float*)d_in[i];
    p.out = (float*)d_out; p.ws = (unsigned char*)d_ws;
#if MK_N_LAUNCHES == 1
    p.ph_lo = 0; p.ph_hi = N_PHASES;
    void* args[] = {&p};
    hipError_t e = hipLaunchCooperativeKernel((const void*)mk_fwd, dim3(grid), dim3(NTHREADS), args, LDS_BYTES, stream);
    if (e != hipSuccess) fprintf(stderr, "kernel_launch: cooperative launch failed: %s (grid %d)\n", hipGetErrorString(e), grid);
#else
    for (int ph = 0; ph < N_PHASES; ++ph) { p.ph_lo = ph; p.ph_hi = ph + 1; hipLaunchKernelGGL(mk_fwd, dim3(grid), dim3(NTHREADS), LDS_BYTES, stream, p); }
#endif
}
```
